# Optimizing an MI355X kernel written in HIP

```python
import math
import jax, jax.numpy as jnp
from jax import lax
import numpy as np

D_MODEL = 1024
BATCH = 8
SEQ = 2048
DEPTH = 4
DEC_BATCH = 128
DEC_SEQ = 4
PAST_LEN = 16384
PAGE_SIZE = 128

N_MIXERS = 3
N_RET = (DEPTH + 2) // 3
N_SSD = (DEPTH + 1) // 3
N_GDN = DEPTH // 3
RET_HEADS = 4
RET_DK = D_MODEL // RET_HEADS
RET_DV = 2 * RET_DK
RET_QK = RET_HEADS * RET_DK
RET_V = RET_HEADS * RET_DV
RET_IN = 2 * RET_QK + 2 * RET_V
ROPE_BASE = 10000.0
SSD_INNER = 2 * D_MODEL
SSD_HEADDIM = 64
SSD_HEADS = SSD_INNER // SSD_HEADDIM
SSD_GROUPS = 8
SSD_STATE = 128
SSD_CONV_DIM = SSD_INNER + 2 * SSD_GROUPS * SSD_STATE
SSD_IN = SSD_INNER + SSD_CONV_DIM + SSD_HEADS
SSD_NORM_GROUP = SSD_INNER // SSD_GROUPS
GDN_KH = 8
GDN_VH = 16
GDN_DK = 128
GDN_DV = 128
GDN_KD = GDN_KH * GDN_DK
GDN_V = GDN_VH * GDN_DV
GDN_CONV_DIM = 2 * GDN_KD + GDN_V
GDN_IN = GDN_CONV_DIM + GDN_V + 2 * GDN_VH
CONV_W = 4
D_FF = 4 * D_MODEL
CHUNK = 64
RMS_EPS = 1e-6

kernel_name = "hybrid_retention_ssd_gdn_decoder_step"


def _chunk_len(L):
    return CHUNK if L % CHUNK == 0 else L


def _rms(x, w=None):
    xf = x.astype(jnp.float32)
    y = xf * lax.rsqrt(jnp.mean(xf * xf, axis=-1, keepdims=True) + RMS_EPS)
    if w is not None:
        y = y * w.astype(jnp.float32)
    return y.astype(x.dtype)


def _l2norm(x):
    xf = x.astype(jnp.float32)
    return xf * lax.rsqrt(jnp.sum(xf * xf, axis=-1, keepdims=True) + RMS_EPS)


def _causal_conv(u, buf, w):
    L = u.shape[1]
    up = jnp.concatenate([buf.astype(u.dtype), u], axis=1)
    out = up[:, 0:L] * w[0]
    for tap in range(1, CONV_W):
        out = out + up[:, tap:tap + L] * w[tap]
    return out, up[:, L:]


def _rotary(x, pos0):
    L, half = x.shape[1], x.shape[-1] // 2
    inv = ROPE_BASE ** (-jnp.arange(half, dtype=jnp.float32) / half)
    ang = (jnp.arange(L, dtype=jnp.float32) + pos0)[:, None] * inv[None, :]
    cos, sin = jnp.cos(ang)[None, :, None, :], jnp.sin(ang)[None, :, None, :]
    xf = x.astype(jnp.float32)
    x1, x2 = xf[..., :half], xf[..., half:]
    return jnp.concatenate([x1 * cos - x2 * sin, x1 * sin + x2 * cos], axis=-1).astype(x.dtype)


def _decay_scan(q, k, v, log_a, s0):
    Bsz, L = q.shape[:2]
    chunk = _chunk_len(L)
    nc = L // chunk

    def blocks(t):
        return t.astype(jnp.float32).reshape((Bsz, nc, chunk) + t.shape[2:])

    qc, kc, vc = blocks(q), blocks(k), blocks(v)
    ct = jnp.moveaxis(jnp.cumsum(blocks(log_a), axis=2), 2, -1)
    incl = jnp.tril(jnp.ones((chunk, chunk), dtype=bool))
    diff = ct[..., :, None] - ct[..., None, :]
    decay = jnp.where(incl, jnp.exp(jnp.where(incl, diff, 0.0)), 0.0)
    scores = jnp.einsum('bctgn,bcsgn->bcgts', qc, kc)
    y_intra = jnp.einsum('bcgrts,bcsgrp->bctgrp', scores[:, :, :, None] * decay, vc)

    def step(S, inp):
        q_c, k_c, v_c, ct_c = inp
        y_c = jnp.einsum('btgn,bgrnp,bgrt->btgrp', q_c, S, jnp.exp(ct_c))
        w_end = jnp.exp(ct_c[..., -1:] - ct_c)
        S = S * jnp.exp(ct_c[..., -1])[..., None, None] + jnp.einsum('bsgn,bgrs,bsgrp->bgrnp', k_c, w_end, v_c)
        return S, y_c

    xs = tuple(jnp.moveaxis(t, 1, 0) for t in (qc, kc, vc, ct))
    s_fin, y_inter = lax.scan(step, s0.astype(jnp.float32), xs)
    y = y_intra + jnp.moveaxis(y_inter, 0, 1)
    return y.reshape((Bsz, L) + v.shape[2:]), s_fin


def _gated_delta_scan(q, k, v, g, beta, s0):
    Bsz, L, H, K = q.shape
    V = v.shape[-1]
    chunk = _chunk_len(L)
    nc = L // chunk

    def blocks(t):
        return t.astype(jnp.float32).reshape((Bsz, nc, chunk) + t.shape[2:])

    qc, kc, vc, bc = blocks(q), blocks(k), blocks(v), blocks(beta)
    gc = jnp.cumsum(blocks(g), axis=2)
    gt = jnp.moveaxis(gc, 2, -1)
    incl = jnp.tril(jnp.ones((chunk, chunk), dtype=bool))
    strict = jnp.tril(jnp.ones((chunk, chunk), dtype=bool), k=-1)
    diff = gt[..., :, None] - gt[..., None, :]
    decay = jnp.where(incl, jnp.exp(jnp.where(incl, diff, 0.0)), 0.0)
    kb = kc * bc[..., None]
    lmat = jnp.where(strict, jnp.einsum('bcthk,bcshk->bchts', kb, kc) * decay, 0.0)
    rhs = jnp.concatenate([jnp.moveaxis(vc * bc[..., None], 2, 3),
                           jnp.moveaxis(kb * jnp.exp(gc)[..., None], 2, 3)], axis=-1)
    eye = jnp.eye(chunk, dtype=jnp.float32)
    sol = lax.linalg.triangular_solve(eye + lmat, rhs, left_side=True, lower=True, unit_diagonal=True)
    u, w = sol[..., :V], sol[..., V:]
    attn = jnp.einsum('bcthk,bcshk->bchts', qc, kc) * decay
    q_dec = qc * jnp.exp(gc)[..., None]
    k_dec = kc * jnp.exp(gc[:, :, -1:] - gc)[..., None]
    c_dec = jnp.exp(gc[:, :, -1])

    def step(S, inp):
        u_c, w_c, attn_c, qd_c, kd_c, cd_c = inp
        v_new = u_c - jnp.einsum('bhtk,bhkv->bhtv', w_c, S)
        o_c = jnp.einsum('bthk,bhkv->bthv', qd_c, S) + jnp.einsum('bhts,bhsv->bthv', attn_c, v_new)
        S = S * cd_c[..., None, None] + jnp.einsum('bshk,bhsv->bhkv', kd_c, v_new)
        return S, o_c

    xs = tuple(jnp.moveaxis(t, 1, 0) for t in (u, w, attn, q_dec, k_dec, c_dec))
    s_fin, o = lax.scan(step, s0.astype(jnp.float32), xs)
    return jnp.moveaxis(o, 0, 1).reshape(Bsz, L, H, V), s_fin


def _retention(h, pos0, s0, w_in, w_out):
    Bsz, L, _ = h.shape
    q, k, v, g = jnp.split(h @ w_in, [RET_QK, 2 * RET_QK, 2 * RET_QK + RET_V], axis=-1)
    q = _rotary(q.reshape(Bsz, L, RET_HEADS, RET_DK), pos0)
    k = _rotary(k.reshape(Bsz, L, RET_HEADS, RET_DK), pos0) * (RET_DK ** -0.5)
    v = v.reshape(Bsz, L, RET_HEADS, 1, RET_DV)
    log_gamma = jnp.log1p(-jnp.exp2(-5.0 - jnp.arange(RET_HEADS, dtype=jnp.float32)))
    log_a = jnp.broadcast_to(log_gamma[:, None], (Bsz, L, RET_HEADS, 1))
    y, s_new = _decay_scan(q, k, v, log_a, s0[:, :, None])
    y = _rms(y[:, :, :, 0])
    out = (jax.nn.silu(g.astype(jnp.float32)) * y.reshape(Bsz, L, RET_V)).astype(h.dtype) @ w_out
    return out, s_new[:, :, 0].astype(s0.dtype)


def _ssd(h, conv_buf, s0, w_in, conv_w, conv_b, dt_bias, a_log, d_skip, norm_w, w_out):
    Bsz, L, _ = h.shape
    R = SSD_HEADS // SSD_GROUPS
    z, xbc, dt = jnp.split(h @ w_in, [SSD_INNER, SSD_INNER + SSD_CONV_DIM], axis=-1)
    xbc, new_buf = _causal_conv(xbc, conv_buf, conv_w)
    xbc = jax.nn.silu(xbc + conv_b)
    xs, b_in, c_out = jnp.split(xbc, [SSD_INNER, SSD_INNER + SSD_GROUPS * SSD_STATE], axis=-1)
    xs = xs.astype(jnp.float32).reshape(Bsz, L, SSD_GROUPS, R, SSD_HEADDIM)
    b_in = b_in.reshape(Bsz, L, SSD_GROUPS, SSD_STATE)
    c_out = c_out.reshape(Bsz, L, SSD_GROUPS, SSD_STATE)
    dt = jax.nn.softplus(dt.astype(jnp.float32) + dt_bias.astype(jnp.float32)).reshape(Bsz, L, SSD_GROUPS, R)
    log_a = dt * (-jnp.exp(a_log.astype(jnp.float32))).reshape(SSD_GROUPS, R)
    s0g = jnp.swapaxes(s0.reshape(Bsz, SSD_GROUPS, R, SSD_HEADDIM, SSD_STATE), -1, -2)
    y, s_new = _decay_scan(c_out, b_in, xs * dt[..., None], log_a, s0g)
    y = y + d_skip.astype(jnp.float32).reshape(SSD_GROUPS, R, 1) * xs
    y = y.reshape(Bsz, L, SSD_INNER) * jax.nn.silu(z.astype(jnp.float32))
    y = _rms(y.reshape(Bsz, L, SSD_GROUPS, SSD_NORM_GROUP)).reshape(Bsz, L, SSD_INNER) * norm_w
    out = y.astype(h.dtype) @ w_out
    s_new = jnp.swapaxes(s_new, -1, -2).reshape(Bsz, SSD_HEADS, SSD_HEADDIM, SSD_STATE)
    return out, s_new.astype(s0.dtype), new_buf


def _gdn(h, conv_buf, s0, w_in, conv_w, dt_bias, a_log, norm_w, w_out):
    Bsz, L, _ = h.shape
    rep = GDN_VH // GDN_KH
    qkv, z, b, a = jnp.split(h @ w_in, [GDN_CONV_DIM, GDN_CONV_DIM + GDN_V, GDN_CONV_DIM + GDN_V + GDN_VH], axis=-1)
    qkv, new_buf = _causal_conv(qkv, conv_buf, conv_w)
    q, k, v = jnp.split(jax.nn.silu(qkv), [GDN_KD, 2 * GDN_KD], axis=-1)
    q = jnp.repeat(_l2norm(q.reshape(Bsz, L, GDN_KH, GDN_DK)), rep, axis=2) * (GDN_DK ** -0.5)
    k = jnp.repeat(_l2norm(k.reshape(Bsz, L, GDN_KH, GDN_DK)), rep, axis=2)
    v = v.reshape(Bsz, L, GDN_VH, GDN_DV)
    beta = jax.nn.sigmoid(b.astype(jnp.float32))
    g = -jnp.exp(a_log.astype(jnp.float32)) * jax.nn.softplus(a.astype(jnp.float32) + dt_bias.astype(jnp.float32))
    o, s_new = _gated_delta_scan(q, k, v, g, beta, s0)
    o = _rms(o, norm_w) * jax.nn.silu(z.astype(jnp.float32).reshape(Bsz, L, GDN_VH, GDN_DV))
    out = o.reshape(Bsz, L, GDN_V).astype(h.dtype) @ w_out
    return out, s_new.astype(s0.dtype), new_buf


def _sqrelu_mlp(h, w_up, w_down):
    return jnp.square(jax.nn.relu(h @ w_up)) @ w_down


def setup_inputs(seed: int = 0) -> dict:
    key = jax.random.key(seed)
    ks = iter(jax.random.split(key, 40))

    def nrm(shape, scale):
        return scale * jax.random.normal(next(ks), shape, jnp.float32)

    def dense(shape):
        return nrm(shape, shape[-2] ** -0.5)

    def gain(shape):
        return 1.0 + nrm(shape, 0.02)

    def dt_bias(shape):
        uu = jax.random.uniform(next(ks), shape, jnp.float32)
        dt = jnp.exp(uu * (math.log(0.1) - math.log(0.001)) + math.log(0.001))
        return dt + jnp.log(-jnp.expm1(-dt))

    def a_log(shape):
        return jnp.log(jax.random.uniform(next(ks), shape, jnp.float32, 1.0, 16.0))

    return {
        "x_prompt": nrm((BATCH, SEQ, D_MODEL), 1.0),
        "x_sample": nrm((DEC_BATCH, DEC_SEQ, D_MODEL), 1.0),
        "state_ret": nrm((N_RET, DEC_BATCH, RET_HEADS, RET_DK, RET_DV), 0.5),
        "state_ssd": nrm((N_SSD, DEC_BATCH, SSD_HEADS, SSD_HEADDIM, SSD_STATE), 0.1),
        "state_ssd_conv": nrm((N_SSD, DEC_BATCH, CONV_W - 1, SSD_CONV_DIM), 1.0),
        "state_gdn": nrm((N_GDN, DEC_BATCH, GDN_VH, GDN_DK, GDN_DV), 0.3),
        "state_gdn_conv": nrm((N_GDN, DEC_BATCH, CONV_W - 1, GDN_CONV_DIM), 1.0),
        "norm_mix": gain((DEPTH, D_MODEL)),
        "norm_mlp": gain((DEPTH, D_MODEL)),
        "norm_final": gain((D_MODEL,)),
        "ret_w_in": dense((N_RET, D_MODEL, RET_IN)),
        "ret_w_out": dense((N_RET, RET_V, D_MODEL)),
        "ssd_w_in": dense((N_SSD, D_MODEL, SSD_IN)),
        "ssd_conv_w": nrm((N_SSD, CONV_W, SSD_CONV_DIM), CONV_W ** -0.5),
        "ssd_conv_b": nrm((N_SSD, SSD_CONV_DIM), 0.01),
        "ssd_dt_bias": dt_bias((N_SSD, SSD_HEADS)),
        "ssd_a_log": a_log((N_SSD, SSD_HEADS)),
        "ssd_d": gain((N_SSD, SSD_HEADS)),
        "ssd_norm": gain((N_SSD, SSD_INNER)),
        "ssd_w_out": dense((N_SSD, SSD_INNER, D_MODEL)),
        "gdn_w_in": dense((N_GDN, D_MODEL, GDN_IN)),
        "gdn_conv_w": nrm((N_GDN, CONV_W, GDN_CONV_DIM), CONV_W ** -0.5),
        "gdn_dt_bias": dt_bias((N_GDN, GDN_VH)),
        "gdn_a_log": a_log((N_GDN, GDN_VH)),
        "gdn_norm": gain((N_GDN, GDN_DV)),
        "gdn_w_out": dense((N_GDN, GDN_V, D_MODEL)),
        "mlp_w_up": dense((DEPTH, D_MODEL, D_FF)),
        "mlp_w_down": dense((DEPTH, D_FF, D_MODEL)),
    }


def reference(x_prompt, x_sample, state_ret, state_ssd, state_ssd_conv, state_gdn, state_gdn_conv,
              norm_mix, norm_mlp, norm_final, ret_w_in, ret_w_out,
              ssd_w_in, ssd_conv_w, ssd_conv_b, ssd_dt_bias, ssd_a_log, ssd_d, ssd_norm, ssd_w_out,
              gdn_w_in, gdn_conv_w, gdn_dt_bias, gdn_a_log, gdn_norm, gdn_w_out,
              mlp_w_up, mlp_w_down):

    def trunk(x, pos0, s_ret, s_ssd, c_ssd, s_gdn, c_gdn):
        n_ret, n_ssd, n_ssdc, n_gdn, n_gdnc = [], [], [], [], []
        for i in range(DEPTH):
            kind, j = i % N_MIXERS, i // N_MIXERS
            h = _rms(x, norm_mix[i])
            if kind == 0:
                out, s = _retention(h, pos0, s_ret[j], ret_w_in[j], ret_w_out[j])
                n_ret.append(s)
            elif kind == 1:
                out, s, c = _ssd(h, c_ssd[j], s_ssd[j], ssd_w_in[j], ssd_conv_w[j], ssd_conv_b[j],
                                 ssd_dt_bias[j], ssd_a_log[j], ssd_d[j], ssd_norm[j], ssd_w_out[j])
                n_ssd.append(s)
                n_ssdc.append(c)
            else:
                out, s, c = _gdn(h, c_gdn[j], s_gdn[j], gdn_w_in[j], gdn_conv_w[j], gdn_dt_bias[j],
                                 gdn_a_log[j], gdn_norm[j], gdn_w_out[j])
                n_gdn.append(s)
                n_gdnc.append(c)
            x = x + out
            x = x + _sqrelu_mlp(_rms(x, norm_mlp[i]), mlp_w_up[i], mlp_w_down[i])
        return (_rms(x, norm_final), jnp.stack(n_ret), jnp.stack(n_ssd), jnp.stack(n_ssdc),
                jnp.stack(n_gdn), jnp.stack(n_gdnc))

    bp = x_prompt.shape[0]
    dt_p = x_prompt.dtype
    y_prompt, p_ret, p_ssd, p_ssd_conv, p_gdn, p_gdn_conv = trunk(
        x_prompt, 0,
        jnp.zeros((N_RET, bp, RET_HEADS, RET_DK, RET_DV), dt_p),
        jnp.zeros((N_SSD, bp, SSD_HEADS, SSD_HEADDIM, SSD_STATE), dt_p),
        jnp.zeros((N_SSD, bp, CONV_W - 1, SSD_CONV_DIM), dt_p),
        jnp.zeros((N_GDN, bp, GDN_VH, GDN_DK, GDN_DV), dt_p),
        jnp.zeros((N_GDN, bp, CONV_W - 1, GDN_CONV_DIM), dt_p))
    y_sample, s_ret, s_ssd, s_ssd_conv, s_gdn, s_gdn_conv = trunk(
        x_sample, PAST_LEN, state_ret, state_ssd, state_ssd_conv, state_gdn, state_gdn_conv)
    return (y_prompt, y_sample, p_ret, p_ssd, p_ssd_conv, p_gdn, p_gdn_conv,
            s_ret, s_ssd, s_ssd_conv, s_gdn, s_gdn_conv)
```

```cpp
#include <hip/hip_runtime.h>
#include <stdint.h>

typedef uint16_t bf16_t;

constexpr int D = 1024;
constexpr int NPB = 8, PL = 2048, NSB = 128, SL = 4;
constexpr int TP = NPB * PL, TS = NSB * SL, T = TP + TS;
constexpr int NSEQ = NPB + NSB;
constexpr int PAST = 16384;
constexpr int NIN = 6400;
constexpr int DFF = 4096;
constexpr int NT = 512;
constexpr float EPS = 1e-6f;

constexpr size_t O_YP = 0;
constexpr size_t O_YS = O_YP + (size_t)TP * D;
constexpr size_t O_PRET = O_YS + (size_t)TS * D;
constexpr size_t RET_ST = (size_t)4 * 256 * 512;
constexpr size_t O_PSSD = O_PRET + 2 * NPB * RET_ST;
constexpr size_t SSD_ST = (size_t)32 * 64 * 128;
constexpr size_t O_PSSDC = O_PSSD + NPB * SSD_ST;
constexpr size_t CONV_ST = (size_t)3 * 4096;
constexpr size_t O_PGDN = O_PSSDC + NPB * CONV_ST;
constexpr size_t GDN_ST = (size_t)16 * 128 * 128;
constexpr size_t O_PGDNC = O_PGDN + NPB * GDN_ST;
constexpr size_t O_SRET = O_PGDNC + NPB * CONV_ST;
constexpr size_t O_SSSD = O_SRET + 2 * NSB * RET_ST;
constexpr size_t O_SSSDC = O_SSSD + NSB * SSD_ST;
constexpr size_t O_SGDN = O_SSSDC + NSB * CONV_ST;
constexpr size_t O_SGDNC = O_SGDN + NSB * GDN_ST;
constexpr size_t O_END = O_SGDNC + NSB * CONV_ST;

struct P {
    const float* in[28];
    float* out;
    float* xres; bf16_t* xb; bf16_t* proj; float* act; float* sm1; float* sm2; float* ymix; bf16_t* ab; bf16_t* u; float* rope;
    bf16_t* w_in[4]; bf16_t* w_out[4]; bf16_t* w_up[4]; bf16_t* w_dn[4];
};

__device__ __forceinline__ float bf2f(bf16_t b) { return __uint_as_float(((uint32_t)b) << 16); }
__device__ __forceinline__ bf16_t f2bf(float f) { uint32_t u = __float_as_uint(f); u += 0x7FFFu + ((u >> 16) & 1u); return (bf16_t)(u >> 16); }
__device__ __forceinline__ float silu_f(float x) { return x / (1.f + __expf(-x)); }
__device__ __forceinline__ float sigmoid_f(float x) { return 1.f / (1.f + __expf(-x)); }
__device__ __forceinline__ float softplus_f(float x) { return fmaxf(x, 0.f) + log1pf(__expf(-fabsf(x))); }

__device__ __forceinline__ float wave_sum(float v) {
#pragma unroll
    for (int o = 32; o > 0; o >>= 1) v += __shfl_xor(v, o);
    return v;
}

__device__ __forceinline__ void seq_info(int s, int& tok0, int& L, int& pos_row0) {
    if (s < NPB) { tok0 = s * PL; L = PL; pos_row0 = 0; }
    else { tok0 = TP + (s - NPB) * SL; L = SL; pos_row0 = PL; }
}

__global__ void __launch_bounds__(256) k_prep_w(const float* __restrict__ W, bf16_t* __restrict__ Wt, int K, int N, int Npad, const float* __restrict__ scale, int period) {
    __shared__ float tile[32][33];
    const int ntn = Npad / 32, ntk = K / 32;
    const int tx = threadIdx.x & 31, ty = threadIdx.x >> 5;
    for (int t = blockIdx.x; t < ntn * ntk; t += gridDim.x) {
        const int tn = t % ntn, tk = t / ntn;
        __syncthreads();
#pragma unroll
        for (int j = 0; j < 4; ++j) {
            const int k = tk * 32 + ty + j * 8, n = tn * 32 + tx;
            float v = 0.f;
            if (n < N) { v = W[(size_t)k * N + n]; if (scale) v *= scale[k % period]; }
            tile[ty + j * 8][tx] = v;
        }
        __syncthreads();
#pragma unroll
        for (int j = 0; j < 4; ++j) {
            const int n = tn * 32 + ty + j * 8, k = tk * 32 + tx;
            Wt[(size_t)n * K + k] = f2bf(tile[tx][ty + j * 8]);
        }
    }
}

__device__ __forceinline__ void sincos_d(double x, double& s, double& c) {
    const double q = rint(x * 0.63661977236758134308);
    double r = fma(-q, 1.57079632679489655800e+00, x);
    r = fma(-q, 6.12323399573676603587e-17, r);
    const double r2 = r * r;
    double sp = -7.6471637318198164759e-13; sp = fma(sp, r2, 1.6059043836821614599e-10); sp = fma(sp, r2, -2.5052108385441718775e-08);
    sp = fma(sp, r2, 2.7557319223985890653e-06); sp = fma(sp, r2, -1.9841269841269841270e-04); sp = fma(sp, r2, 8.3333333333333333333e-03);
    sp = fma(sp, r2, -1.6666666666666666667e-01); const double sn = fma(sp * r2, r, r);
    double cp = 4.7794773323873852974e-14; cp = fma(cp, r2, -1.1470745597729724714e-11); cp = fma(cp, r2, 2.0876756987868098979e-09);
    cp = fma(cp, r2, -2.7557319223985890653e-07); cp = fma(cp, r2, 2.4801587301587301587e-05); cp = fma(cp, r2, -1.3888888888888888889e-03);
    cp = fma(cp, r2, 4.1666666666666666667e-02); cp = fma(cp, r2, -0.5); const double cs = fma(cp, r2, 1.0);
    const int qi = ((int)q) & 3;
    s = (qi == 0) ? sn : (qi == 1) ? cs : (qi == 2) ? -sn : -cs;
    c = (qi == 0) ? cs : (qi == 1) ? -sn : (qi == 2) ? -cs : sn;
}
__global__ void __launch_bounds__(256) k_rope(float* __restrict__ rope) {
    const int idx = blockIdx.x * blockDim.x + threadIdx.x;
    if (idx >= (PL + SL) * 128) return;
    const int p = idx >> 7, i = idx & 127;
    const double pos = (p < PL) ? (double)p : (double)(PAST + p - PL);
    double inv = 1.0, b = 0.93057204092969897; int e = i;
    while (e) { if (e & 1) inv *= b; b *= b; e >>= 1; }
    double s, c; sincos_d(pos * inv, s, c);
    rope[(size_t)idx * 2] = (float)c; rope[(size_t)idx * 2 + 1] = (float)s;
}

__global__ void __launch_bounds__(256) k_copy_x(const float* __restrict__ xp, const float* __restrict__ xs, float* __restrict__ xres) {
    const size_t n4p = (size_t)TP * D / 4, n4 = (size_t)T * D / 4;
    for (size_t i = (size_t)blockIdx.x * blockDim.x + threadIdx.x; i < n4; i += (size_t)gridDim.x * blockDim.x) {
        const float4 v = (i < n4p) ? ((const float4*)xp)[i] : ((const float4*)xs)[i - n4p];
        ((float4*)xres)[i] = v;
    }
}

__global__ void __launch_bounds__(NT) k_norm_prep(const float* __restrict__ xres, bf16_t* __restrict__ xb) {
    __shared__ float red[8];
    const int tid = threadIdx.x;
    for (int row = blockIdx.x; row < T; row += gridDim.x) {
        const float2 v = ((const float2*)(xres + (size_t)row * D))[tid];
        float ss = wave_sum(v.x * v.x + v.y * v.y);
        __syncthreads();
        if ((tid & 63) == 0) red[tid >> 6] = ss;
        __syncthreads();
        float tot = 0.f;
#pragma unroll
        for (int i = 0; i < 8; ++i) tot += red[i];
        const float rs = rsqrtf(tot * (1.f / D) + EPS);
        const uint32_t pk = (uint32_t)f2bf(v.x * rs) | ((uint32_t)f2bf(v.y * rs) << 16);
        ((uint32_t*)(xb + (size_t)row * D))[tid] = pk;
    }
}

__global__ void __launch_bounds__(NT) k_final_norm(const float* __restrict__ xres, const float* __restrict__ w, float* __restrict__ out) {
    __shared__ float red[8];
    const int tid = threadIdx.x;
    for (int row = blockIdx.x; row < T; row += gridDim.x) {
        const float2 v = ((const float2*)(xres + (size_t)row * D))[tid];
        float ss = wave_sum(v.x * v.x + v.y * v.y);
        __syncthreads();
        if ((tid & 63) == 0) red[tid >> 6] = ss;
        __syncthreads();
        float tot = 0.f;
#pragma unroll
        for (int i = 0; i < 8; ++i) tot += red[i];
        const float rs = rsqrtf(tot * (1.f / D) + EPS);
        const float2 wv = ((const float2*)w)[tid];
        float2 o; o.x = v.x * rs * wv.x; o.y = v.y * rs * wv.y;
        ((float2*)(out + (size_t)row * D))[tid] = o;
    }
}

template <int KIND>
__global__ void __launch_bounds__(NT) k_gate(const float* __restrict__ ymix, const bf16_t* __restrict__ proj, bf16_t* __restrict__ ab) {
    __shared__ float red[8];
    const int tid = threadIdx.x, e = tid * 4;
    for (int row = blockIdx.x; row < T; row += gridDim.x) {
        const float4 y = *(const float4*)(ymix + (size_t)row * 2048 + e);
        const int gcol = (KIND == 0) ? 4096 + e : (KIND == 1) ? e : 4096 + e;
        const uint2 graw = *(const uint2*)(proj + (size_t)row * NIN + gcol);
        float g[4] = { bf2f((bf16_t)(graw.x & 0xffff)), bf2f((bf16_t)(graw.x >> 16)), bf2f((bf16_t)(graw.y & 0xffff)), bf2f((bf16_t)(graw.y >> 16)) };
        float v[4] = { y.x, y.y, y.z, y.w };
        float o[4];
        if (KIND == 0) {
            float ss = wave_sum(v[0] * v[0] + v[1] * v[1] + v[2] * v[2] + v[3] * v[3]);
            __syncthreads();
            if ((tid & 63) == 0) red[tid >> 6] = ss;
            __syncthreads();
            const int h = tid >> 7;
            const float rs = rsqrtf((red[2 * h] + red[2 * h + 1]) * (1.f / 512.f) + EPS);
#pragma unroll
            for (int j = 0; j < 4; ++j) o[j] = silu_f(g[j]) * v[j] * rs;
        } else if (KIND == 1) {
#pragma unroll
            for (int j = 0; j < 4; ++j) v[j] *= silu_f(g[j]);
            const float ss = wave_sum(v[0] * v[0] + v[1] * v[1] + v[2] * v[2] + v[3] * v[3]);
            const float rs = rsqrtf(ss * (1.f / 256.f) + EPS);
#pragma unroll
            for (int j = 0; j < 4; ++j) o[j] = v[j] * rs;
        } else {
            float ss = v[0] * v[0] + v[1] * v[1] + v[2] * v[2] + v[3] * v[3];
#pragma unroll
            for (int of = 16; of > 0; of >>= 1) ss += __shfl_xor(ss, of);
            const float rs = rsqrtf(ss * (1.f / 128.f) + EPS);
#pragma unroll
            for (int j = 0; j < 4; ++j) o[j] = v[j] * rs * silu_f(g[j]);
        }
        uint2 pk; pk.x = (uint32_t)f2bf(o[0]) | ((uint32_t)f2bf(o[1]) << 16); pk.y = (uint32_t)f2bf(o[2]) | ((uint32_t)f2bf(o[3]) << 16);
        *(uint2*)(ab + (size_t)row * 2048 + e) = pk;
    }
}

template <int MODE>
__global__ void __launch_bounds__(NT) k_conv_pre(const bf16_t* __restrict__ proj, const float* __restrict__ cstate, const float* __restrict__ cw, const float* __restrict__ cb,
                                                 const float* __restrict__ dt_bias, const float* __restrict__ a_log,
                                                 float* __restrict__ act, float* __restrict__ sm1, float* __restrict__ sm2,
                                                 float* __restrict__ pconv, float* __restrict__ sconv) {
    __shared__ float buf[4096];
    const int tid = threadIdx.x;
    const int c0 = (MODE == 1) ? 2048 : 0;
    for (int row = blockIdx.x; row < T; row += gridDim.x) {
        int t, L, b; bool samp;
        if (row < TP) { b = row / PL; t = row % PL; L = PL; samp = false; } else { b = (row - TP) / SL; t = (row - TP) % SL; L = SL; samp = true; }
        __syncthreads();
        for (int c = tid; c < 4096; c += NT) {
            float acc = (MODE == 1) ? cb[c] : 0.f;
#pragma unroll
            for (int tap = 0; tap < 4; ++tap) {
                const int i = t + tap;
                float val;
                if (i < 3) val = samp ? cstate[((size_t)b * 3 + i) * 4096 + c] : 0.f;
                else val = bf2f(proj[(size_t)(row - t + i - 3) * NIN + c0 + c]);
                acc += val * cw[tap * 4096 + c];
            }
            const float a = silu_f(acc);
            if (MODE == 1) act[(size_t)row * 4096 + c] = a; else buf[c] = a;
            if (t >= L - 3) {
                const float raw = bf2f(proj[(size_t)row * NIN + c0 + c]);
                float* dst = samp ? sconv : pconv;
                dst[((size_t)b * 3 + (t - (L - 3))) * 4096 + c] = raw;
            }
        }
        if (MODE == 1) {
            if (tid < 32) sm1[(size_t)row * 32 + tid] = softplus_f(bf2f(proj[(size_t)row * NIN + 6144 + tid]) + dt_bias[tid]);
        } else {
            if (tid < 16) {
                sm1[(size_t)row * 16 + tid] = sigmoid_f(bf2f(proj[(size_t)row * NIN + 6144 + tid]));
                sm2[(size_t)row * 16 + tid] = -__expf(a_log[tid]) * softplus_f(bf2f(proj[(size_t)row * NIN + 6160 + tid]) + dt_bias[tid]);
            }
            __syncthreads();
            const int w = tid >> 6, lane = tid & 63;
#pragma unroll
            for (int hh = 0; hh < 2; ++hh) {
                const int head = w * 2 + hh;
                const float2 v = *(const float2*)(buf + head * 128 + lane * 2);
                const float ss = wave_sum(v.x * v.x + v.y * v.y);
                const float sc = rsqrtf(ss + EPS) * ((head < 8) ? 0.08838834764831845f : 1.f);
                float2 o; o.x = v.x * sc; o.y = v.y * sc;
                *(float2*)(act + (size_t)row * 4096 + head * 128 + lane * 2) = o;
            }
            for (int c = 2048 + tid; c < 4096; c += NT) act[(size_t)row * 4096 + c] = buf[c];
        }
    }
}

__global__ void __launch_bounds__(NT) k_ret_scan(const bf16_t* __restrict__ proj, const float* __restrict__ rope, const float* __restrict__ s_in  ,
                                                 float* __restrict__ ymix, float* __restrict__ p_out, float* __restrict__ s_out) {
    __shared__ float qs[4][256], ks[4][256], vs[4][64], red[8][4][64];
    const int tid = threadIdx.x, lane = tid & 63, wv = tid >> 6, c4 = tid & 15, dg = tid >> 4;
    for (int unit = blockIdx.x; unit < NSEQ * 32; unit += gridDim.x) {
        const int s = unit >> 5, h = (unit >> 3) & 3, sl = unit & 7;
        int tok0, L, prow0; seq_info(s, tok0, L, prow0);
        const float gamma = 1.f - exp2f(-5.f - (float)h);
        const size_t st_off = (((size_t)(s < NPB ? s : s - NPB) * 4 + h) * 256) * 512 + sl * 64 + c4 * 4;
        float S[8][4];
#pragma unroll
        for (int r = 0; r < 8; ++r) {
            float4 v = make_float4(0.f, 0.f, 0.f, 0.f);
            if (s >= NPB) v = *(const float4*)(s_in + st_off + (size_t)(dg * 8 + r) * 512);
            S[r][0] = v.x; S[r][1] = v.y; S[r][2] = v.z; S[r][3] = v.w;
        }
        for (int t0 = 0; t0 < L; t0 += 4) {
            __syncthreads();
            {
                const int tt = tid >> 7, i = tid & 127;
                const size_t rb = (size_t)(tok0 + t0 + tt) * NIN;
                const float2 cs = *(const float2*)(rope + ((size_t)(prow0 + t0 + tt) * 128 + i) * 2);
                const float q1 = bf2f(proj[rb + h * 256 + i]), q2 = bf2f(proj[rb + h * 256 + 128 + i]);
                const float k1 = bf2f(proj[rb + 1024 + h * 256 + i]), k2 = bf2f(proj[rb + 1024 + h * 256 + 128 + i]);
                qs[tt][i] = q1 * cs.x - q2 * cs.y; qs[tt][i + 128] = q1 * cs.y + q2 * cs.x;
                ks[tt][i] = (k1 * cs.x - k2 * cs.y) * 0.0625f; ks[tt][i + 128] = (k1 * cs.y + k2 * cs.x) * 0.0625f;
                if (tid < 256) { const int t2 = tid >> 6, c = tid & 63; vs[t2][c] = bf2f(proj[(size_t)(tok0 + t0 + t2) * NIN + 2048 + h * 512 + sl * 64 + c]); }
            }
            __syncthreads();
            float yp[4][4];
#pragma unroll
            for (int tt = 0; tt < 4; ++tt) {
                const float4 vv = *(const float4*)(&vs[tt][c4 * 4]);
                const float vvv[4] = { vv.x, vv.y, vv.z, vv.w };
#pragma unroll
                for (int j = 0; j < 4; ++j) yp[tt][j] = 0.f;
#pragma unroll
                for (int r = 0; r < 8; ++r) {
                    const float kk = ks[tt][dg * 8 + r], qq = qs[tt][dg * 8 + r];
#pragma unroll
                    for (int j = 0; j < 4; ++j) { S[r][j] = gamma * S[r][j] + kk * vvv[j]; yp[tt][j] += qq * S[r][j]; }
                }
            }
#pragma unroll
            for (int tt = 0; tt < 4; ++tt)
#pragma unroll
                for (int j = 0; j < 4; ++j) { float v = yp[tt][j]; v += __shfl_xor(v, 16); v += __shfl_xor(v, 32); yp[tt][j] = v; }
            if (lane < 16) {
#pragma unroll
                for (int tt = 0; tt < 4; ++tt) *(float4*)(&red[wv][tt][c4 * 4]) = make_float4(yp[tt][0], yp[tt][1], yp[tt][2], yp[tt][3]);
            }
            __syncthreads();
            if (tid < 256) {
                const int tt = tid >> 6, c = tid & 63; float a = 0.f;
#pragma unroll
                for (int w = 0; w < 8; ++w) a += red[w][tt][c];
                ymix[(size_t)(tok0 + t0 + tt) * 2048 + h * 512 + sl * 64 + c] = a;
            }
        }
        float* so = (s < NPB) ? p_out : s_out;
#pragma unroll
        for (int r = 0; r < 8; ++r) *(float4*)(so + st_off + (size_t)(dg * 8 + r) * 512) = make_float4(S[r][0], S[r][1], S[r][2], S[r][3]);
    }
}

__global__ void __launch_bounds__(NT) k_ssd_scan(const float* __restrict__ act, const float* __restrict__ dtv, const float* __restrict__ a_log, const float* __restrict__ dskip,
                                                 const float* __restrict__ s_in  , float* __restrict__ ymix, float* __restrict__ p_out, float* __restrict__ s_out) {
    __shared__ float xs[4][64], Bs[4][128], Cs[4][128], dts[4];
    const int tid = threadIdx.x, n4 = tid & 31, pg = tid >> 5;
    for (int unit = blockIdx.x; unit < NSEQ * 32; unit += gridDim.x) {
        const int s = unit >> 5, hh = unit & 31, g = hh >> 2;
        int tok0, L, prow0; seq_info(s, tok0, L, prow0);
        const float A = -__expf(a_log[hh]), Dk = dskip[hh];
        const size_t st_off = (((size_t)(s < NPB ? s : s - NPB) * 32 + hh) * 64) * 128 + n4 * 4;
        float S[4][4];
#pragma unroll
        for (int r = 0; r < 4; ++r) {
            float4 v = make_float4(0.f, 0.f, 0.f, 0.f);
            if (s >= NPB) v = *(const float4*)(s_in + st_off + (size_t)(pg * 4 + r) * 128);
            S[r][0] = v.x; S[r][1] = v.y; S[r][2] = v.z; S[r][3] = v.w;
        }
        for (int t0 = 0; t0 < L; t0 += 4) {
            __syncthreads();
            {
                const int tt = tid >> 7, i = tid & 127;
                const size_t rb = (size_t)(tok0 + t0 + tt) * 4096;
                Bs[tt][i] = act[rb + 2048 + g * 128 + i];
                Cs[tt][i] = act[rb + 3072 + g * 128 + i];
                if (i < 64) xs[tt][i] = act[rb + hh * 64 + i];
                if (i == 64) dts[tt] = dtv[(size_t)(tok0 + t0 + tt) * 32 + hh];
            }
            __syncthreads();
#pragma unroll
            for (int tt = 0; tt < 4; ++tt) {
                const float dt = dts[tt], a = __expf(dt * A);
                const float4 bv = *(const float4*)(&Bs[tt][n4 * 4]), cv = *(const float4*)(&Cs[tt][n4 * 4]);
                const float bb[4] = { bv.x, bv.y, bv.z, bv.w }, cc[4] = { cv.x, cv.y, cv.z, cv.w };
                float yp[4];
#pragma unroll
                for (int r = 0; r < 4; ++r) {
                    const float xv = xs[tt][pg * 4 + r], xd = xv * dt;
                    float acc = 0.f;
#pragma unroll
                    for (int j = 0; j < 4; ++j) { S[r][j] = a * S[r][j] + xd * bb[j]; acc += S[r][j] * cc[j]; }
#pragma unroll
                    for (int of = 16; of > 0; of >>= 1) acc += __shfl_xor(acc, of);
                    yp[r] = acc + Dk * xv;
                }
                if (n4 == 0) *(float4*)(ymix + (size_t)(tok0 + t0 + tt) * 2048 + hh * 64 + pg * 4) = make_float4(yp[0], yp[1], yp[2], yp[3]);
            }
        }
        float* so = (s < NPB) ? p_out : s_out;
#pragma unroll
        for (int r = 0; r < 4; ++r) *(float4*)(so + st_off + (size_t)(pg * 4 + r) * 128) = make_float4(S[r][0], S[r][1], S[r][2], S[r][3]);
    }
}

__global__ void __launch_bounds__(NT) k_gdn_scan(const float* __restrict__ act, const float* __restrict__ betav, const float* __restrict__ gv,
                                                 const float* __restrict__ s_in  , float* __restrict__ ymix, float* __restrict__ p_out, float* __restrict__ s_out) {
    __shared__ float qs[4][128], ks[4][128], vs[4][128], gs[4], bs[4], red[2][8][128], ored[8][4][128];
    const int tid = threadIdx.x, lane = tid & 63, wv = tid >> 6, v4 = tid & 31, kg = tid >> 5;
    for (int unit = blockIdx.x; unit < NSEQ * 16; unit += gridDim.x) {
        const int s = unit >> 4, hv = unit & 15, hk = hv >> 1;
        int tok0, L, prow0; seq_info(s, tok0, L, prow0);
        const size_t st_off = (((size_t)(s < NPB ? s : s - NPB) * 16 + hv) * 128) * 128 + v4 * 4;
        float S[8][4];
#pragma unroll
        for (int r = 0; r < 8; ++r) {
            float4 v = make_float4(0.f, 0.f, 0.f, 0.f);
            if (s >= NPB) v = *(const float4*)(s_in + st_off + (size_t)(kg * 8 + r) * 128);
            S[r][0] = v.x; S[r][1] = v.y; S[r][2] = v.z; S[r][3] = v.w;
        }
        for (int t0 = 0; t0 < L; t0 += 4) {
            __syncthreads();
            {
                const int tt = tid >> 7, i = tid & 127;
                const size_t rb = (size_t)(tok0 + t0 + tt) * 4096;
                qs[tt][i] = act[rb + hk * 128 + i];
                ks[tt][i] = act[rb + 1024 + hk * 128 + i];
                vs[tt][i] = act[rb + 2048 + hv * 128 + i];
                if (i == 0) { gs[tt] = gv[(size_t)(tok0 + t0 + tt) * 16 + hv]; bs[tt] = betav[(size_t)(tok0 + t0 + tt) * 16 + hv]; }
            }
            __syncthreads();
            float op[4][4];
#pragma unroll
            for (int tt = 0; tt < 4; ++tt) {
                const float eg = __expf(gs[tt]), beta = bs[tt];
                float kr[8], part[4] = { 0.f, 0.f, 0.f, 0.f };
#pragma unroll
                for (int r = 0; r < 8; ++r) {
                    kr[r] = ks[tt][kg * 8 + r];
#pragma unroll
                    for (int j = 0; j < 4; ++j) { S[r][j] *= eg; part[j] += S[r][j] * kr[r]; }
                }
#pragma unroll
                for (int j = 0; j < 4; ++j) part[j] += __shfl_xor(part[j], 32);
                if (lane < 32) *(float4*)(&red[tt & 1][wv][v4 * 4]) = make_float4(part[0], part[1], part[2], part[3]);
                __syncthreads();
                float kS[4] = { 0.f, 0.f, 0.f, 0.f };
#pragma unroll
                for (int w = 0; w < 8; ++w) { const float4 pv = *(const float4*)(&red[tt & 1][w][v4 * 4]); kS[0] += pv.x; kS[1] += pv.y; kS[2] += pv.z; kS[3] += pv.w; }
                const float4 vv = *(const float4*)(&vs[tt][v4 * 4]);
                const float dl[4] = { beta * (vv.x - kS[0]), beta * (vv.y - kS[1]), beta * (vv.z - kS[2]), beta * (vv.w - kS[3]) };
#pragma unroll
                for (int j = 0; j < 4; ++j) op[tt][j] = 0.f;
#pragma unroll
                for (int r = 0; r < 8; ++r) {
                    const float qq = qs[tt][kg * 8 + r];
#pragma unroll
                    for (int j = 0; j < 4; ++j) { S[r][j] += kr[r] * dl[j]; op[tt][j] += S[r][j] * qq; }
                }
            }
#pragma unroll
            for (int tt = 0; tt < 4; ++tt) {
#pragma unroll
                for (int j = 0; j < 4; ++j) op[tt][j] += __shfl_xor(op[tt][j], 32);
                if (lane < 32) *(float4*)(&ored[wv][tt][v4 * 4]) = make_float4(op[tt][0], op[tt][1], op[tt][2], op[tt][3]);
            }
            __syncthreads();
            {
                const int tt = tid >> 7, c = tid & 127; float a = 0.f;
#pragma unroll
                for (int w = 0; w < 8; ++w) a += ored[w][tt][c];
                ymix[(size_t)(tok0 + t0 + tt) * 2048 + hv * 128 + c] = a;
            }
        }
        float* so = (s < NPB) ? p_out : s_out;
#pragma unroll
        for (int r = 0; r < 8; ++r) *(float4*)(so + st_off + (size_t)(kg * 8 + r) * 128) = make_float4(S[r][0], S[r][1], S[r][2], S[r][3]);
    }
}

template <int EPI>
__global__ void __launch_bounds__(NT) k_gemm(const bf16_t* __restrict__ A, const bf16_t* __restrict__ Bt, int M, int N, int K, bf16_t* __restrict__ Cb, float* __restrict__ Cf, int ldc) {
    __shared__ float As[16][132], Bs[16][132];
    const int tid = threadIdx.x, tx = tid & 31, ty = tid >> 5;
    const int ntm = M / 128, ntn = N / 128;
    for (int tile = blockIdx.x; tile < ntm * ntn; tile += gridDim.x) {
        const int m0 = (tile / ntn) * 128, n0 = (tile % ntn) * 128;
        float acc[8][4];
#pragma unroll
        for (int i = 0; i < 8; ++i)
#pragma unroll
            for (int j = 0; j < 4; ++j) acc[i][j] = 0.f;
        const int lr = tid >> 2, lk = (tid & 3) * 4;
        for (int k0 = 0; k0 < K; k0 += 16) {
            const uint2 av = *(const uint2*)(A + (size_t)(m0 + lr) * K + k0 + lk);
            const uint2 bv = *(const uint2*)(Bt + (size_t)(n0 + lr) * K + k0 + lk);
            __syncthreads();
            As[lk + 0][lr] = bf2f((bf16_t)(av.x & 0xffff)); As[lk + 1][lr] = bf2f((bf16_t)(av.x >> 16)); As[lk + 2][lr] = bf2f((bf16_t)(av.y & 0xffff)); As[lk + 3][lr] = bf2f((bf16_t)(av.y >> 16));
            Bs[lk + 0][lr] = bf2f((bf16_t)(bv.x & 0xffff)); Bs[lk + 1][lr] = bf2f((bf16_t)(bv.x >> 16)); Bs[lk + 2][lr] = bf2f((bf16_t)(bv.y & 0xffff)); Bs[lk + 3][lr] = bf2f((bf16_t)(bv.y >> 16));
            __syncthreads();
#pragma unroll
            for (int k = 0; k < 16; ++k) {
                const float4 a0 = *(const float4*)(&As[k][ty * 8]), a1 = *(const float4*)(&As[k][ty * 8 + 4]), b = *(const float4*)(&Bs[k][tx * 4]);
                const float a[8] = { a0.x, a0.y, a0.z, a0.w, a1.x, a1.y, a1.z, a1.w }, bb[4] = { b.x, b.y, b.z, b.w };
#pragma unroll
                for (int i = 0; i < 8; ++i)
#pragma unroll
                    for (int j = 0; j < 4; ++j) acc[i][j] += a[i] * bb[j];
            }
        }
#pragma unroll
        for (int i = 0; i < 8; ++i) {
            const int m = m0 + ty * 8 + i, n = n0 + tx * 4;
            if (EPI == 2) {
                float4* p = (float4*)(Cf + (size_t)m * ldc + n); float4 o = *p;
                o.x += acc[i][0]; o.y += acc[i][1]; o.z += acc[i][2]; o.w += acc[i][3]; *p = o;
            } else {
                float v[4] = { acc[i][0], acc[i][1], acc[i][2], acc[i][3] };
                if (EPI == 1) {
#pragma unroll
                    for (int j = 0; j < 4; ++j) { const float r = fmaxf(v[j], 0.f); v[j] = r * r; }
                }
                uint2 pk; pk.x = (uint32_t)f2bf(v[0]) | ((uint32_t)f2bf(v[1]) << 16); pk.y = (uint32_t)f2bf(v[2]) | ((uint32_t)f2bf(v[3]) << 16);
                *(uint2*)(Cb + (size_t)m * ldc + n) = pk;
            }
        }
    }
}

static inline size_t al256(size_t x) { return (x + 255) & ~(size_t)255; }

extern "C" void kernel_launch(void* const* d_in, const int* in_sizes, int n_in, void* d_out, int out_size, void* d_ws, size_t ws_size, hipStream_t stream) {
    P p{};
    for (int i = 0; i < 28; ++i) p.in[i] = (const float*)d_in[i];
    p.out = (float*)d_out;
    char* w = (char*)d_ws; size_t off = 65536;
    auto take = [&](size_t bytes) { char* r = w + off; off = al256(off + bytes); return r; };
    p.xres = (float*)take((size_t)T * D * 4);
    p.xb = (bf16_t*)take((size_t)T * D * 2);
    p.proj = (bf16_t*)take((size_t)T * NIN * 2);
    p.act = (float*)take((size_t)T * 4096 * 4);
    p.sm1 = (float*)take((size_t)T * 32 * 4);
    p.sm2 = (float*)take((size_t)T * 32 * 4);
    p.ymix = (float*)take((size_t)T * 2048 * 4);
    p.ab = (bf16_t*)take((size_t)T * 2048 * 2);
    p.u = (bf16_t*)take((size_t)T * DFF * 2);
    p.rope = (float*)take((size_t)(PL + SL) * 128 * 2 * 4);
    for (int l = 0; l < 4; ++l) {
        p.w_in[l] = (bf16_t*)take((size_t)NIN * D * 2);
        p.w_out[l] = (bf16_t*)take((size_t)D * 2048 * 2);
        p.w_up[l] = (bf16_t*)take((size_t)DFF * D * 2);
        p.w_dn[l] = (bf16_t*)take((size_t)D * DFF * 2);
    }
    const float* norm_mix = p.in[7]; const float* norm_mlp = p.in[8];
    const int G = 1024;
    for (int l = 0; l < 4; ++l) {
        const int kind = l % 3, j = l / 3;
        if (kind == 0) {
            k_prep_w<<<G, 256, 0, stream>>>(p.in[10] + (size_t)j * D * 6144, p.w_in[l], D, 6144, NIN, norm_mix + l * D, D);
            k_prep_w<<<G, 256, 0, stream>>>(p.in[11] + (size_t)j * 2048 * D, p.w_out[l], 2048, D, D, nullptr, 1);
        } else if (kind == 1) {
            k_prep_w<<<G, 256, 0, stream>>>(p.in[12], p.w_in[l], D, 6176, NIN, norm_mix + l * D, D);
            k_prep_w<<<G, 256, 0, stream>>>(p.in[19], p.w_out[l], 2048, D, D, p.in[18], 2048);
        } else {
            k_prep_w<<<G, 256, 0, stream>>>(p.in[20], p.w_in[l], D, 6176, NIN, norm_mix + l * D, D);
            k_prep_w<<<G, 256, 0, stream>>>(p.in[25], p.w_out[l], 2048, D, D, p.in[24], 128);
        }
        k_prep_w<<<G, 256, 0, stream>>>(p.in[26] + (size_t)l * D * DFF, p.w_up[l], D, DFF, DFF, norm_mlp + l * D, D);
        k_prep_w<<<G, 256, 0, stream>>>(p.in[27] + (size_t)l * DFF * D, p.w_dn[l], DFF, D, D, nullptr, 1);
    }
    k_rope<<<((PL + SL) * 128 + 255) / 256, 256, 0, stream>>>(p.rope);
    k_copy_x<<<G, 256, 0, stream>>>(p.in[0], p.in[1], p.xres);
    for (int l = 0; l < 4; ++l) {
        const int kind = l % 3, j = l / 3;
        k_norm_prep<<<G, NT, 0, stream>>>(p.xres, p.xb);
        k_gemm<0><<<G, NT, 0, stream>>>(p.xb, p.w_in[l], T, NIN, D, p.proj, nullptr, NIN);
        if (kind == 0) {
            k_ret_scan<<<G, NT, 0, stream>>>(p.proj, p.rope, p.in[2] + (size_t)j * NSB * RET_ST, p.ymix,
                                             p.out + O_PRET + (size_t)j * NPB * RET_ST, p.out + O_SRET + (size_t)j * NSB * RET_ST);
            k_gate<0><<<G, NT, 0, stream>>>(p.ymix, p.proj, p.ab);
        } else if (kind == 1) {
            k_conv_pre<1><<<G, NT, 0, stream>>>(p.proj, p.in[4], p.in[13], p.in[14], p.in[15], p.in[16], p.act, p.sm1, p.sm2, p.out + O_PSSDC, p.out + O_SSSDC);
            k_ssd_scan<<<G, NT, 0, stream>>>(p.act, p.sm1, p.in[16], p.in[17], p.in[3], p.ymix, p.out + O_PSSD, p.out + O_SSSD);
            k_gate<1><<<G, NT, 0, stream>>>(p.ymix, p.proj, p.ab);
        } else {
            k_conv_pre<2><<<G, NT, 0, stream>>>(p.proj, p.in[6], p.in[21], nullptr, p.in[22], p.in[23], p.act, p.sm1, p.sm2, p.out + O_PGDNC, p.out + O_SGDNC);
            k_gdn_scan<<<G, NT, 0, stream>>>(p.act, p.sm1, p.sm2, p.in[5], p.ymix, p.out + O_PGDN, p.out + O_SGDN);
            k_gate<2><<<G, NT, 0, stream>>>(p.ymix, p.proj, p.ab);
        }
        k_gemm<2><<<G, NT, 0, stream>>>(p.ab, p.w_out[l], T, D, 2048, nullptr, p.xres, D);
        k_norm_prep<<<G, NT, 0, stream>>>(p.xres, p.xb);
        k_gemm<1><<<G, NT, 0, stream>>>(p.xb, p.w_up[l], T, DFF, D, p.u, nullptr, DFF);
        k_gemm<2><<<G, NT, 0, stream>>>(p.u, p.w_dn[l], T, D, DFF, nullptr, p.xres, D);
    }
    k_final_norm<<<G, NT, 0, stream>>>(p.xres, p.in[9], p.out);
}
```

```cpp
#include <hip/hip_runtime.h>
#include <stdint.h>

typedef uint16_t bf16_t;

constexpr int D = 1024;
constexpr int NPB = 8, PL = 2048, NSB = 128, SL = 4;
constexpr int TP = NPB * PL, TS = NSB * SL, T = TP + TS;
constexpr int NSEQ = NPB + NSB;
constexpr int PAST = 16384;
constexpr int NIN = 6400;
constexpr int DFF = 4096;
constexpr int NT = 512;
constexpr float EPS = 1e-6f;

constexpr size_t O_YP = 0;
constexpr size_t O_YS = O_YP + (size_t)TP * D;
constexpr size_t O_PRET = O_YS + (size_t)TS * D;
constexpr size_t RET_ST = (size_t)4 * 256 * 512;
constexpr size_t O_PSSD = O_PRET + 2 * NPB * RET_ST;
constexpr size_t SSD_ST = (size_t)32 * 64 * 128;
constexpr size_t O_PSSDC = O_PSSD + NPB * SSD_ST;
constexpr size_t CONV_ST = (size_t)3 * 4096;
constexpr size_t O_PGDN = O_PSSDC + NPB * CONV_ST;
constexpr size_t GDN_ST = (size_t)16 * 128 * 128;
constexpr size_t O_PGDNC = O_PGDN + NPB * GDN_ST;
constexpr size_t O_SRET = O_PGDNC + NPB * CONV_ST;
constexpr size_t O_SSSD = O_SRET + 2 * NSB * RET_ST;
constexpr size_t O_SSSDC = O_SSSD + NSB * SSD_ST;
constexpr size_t O_SGDN = O_SSSDC + NSB * CONV_ST;
constexpr size_t O_SGDNC = O_SGDN + NSB * GDN_ST;
constexpr size_t O_END = O_SGDNC + NSB * CONV_ST;

struct P {
    const float* in[28];
    float* out; unsigned* bar;
    float* xres; float* xres2; bf16_t* xb; bf16_t* proj; float* act; float* sm1; float* sm2; float* ymix; bf16_t* ab; bf16_t* u; float* rope;
    bf16_t* w_in[4]; bf16_t* w_out[4]; bf16_t* w_up[4]; bf16_t* w_dn[4];
};

__device__ __forceinline__ float bf2f(bf16_t b) { return __uint_as_float(((uint32_t)b) << 16); }
__device__ __forceinline__ bf16_t f2bf(float f) { uint32_t u = __float_as_uint(f); u += 0x7FFFu + ((u >> 16) & 1u); return (bf16_t)(u >> 16); }
__device__ __forceinline__ float silu_f(float x) { return x / (1.f + __expf(-x)); }
__device__ __forceinline__ float sigmoid_f(float x) { return 1.f / (1.f + __expf(-x)); }
__device__ __forceinline__ float softplus_f(float x) { return fmaxf(x, 0.f) + log1pf(__expf(-fabsf(x))); }

__device__ __forceinline__ int opaque_tid() { int t = threadIdx.x; asm volatile("" : "+v"(t)); return t; }

__device__ __forceinline__ float wave_sum(float v) {
#pragma unroll
    for (int o = 32; o > 0; o >>= 1) v += __shfl_xor(v, o);
    return v;
}

__device__ __forceinline__ void seq_info(int s, int& tok0, int& L, int& pos_row0) {
    if (s < NPB) { tok0 = s * PL; L = PL; pos_row0 = 0; }
    else { tok0 = TP + (s - NPB) * SL; L = SL; pos_row0 = PL; }
}


#define XB_TMO      128
#define XB_XCNT(j)  (256  + 64 * (j))
#define XB_XSUB(j)  (1280 + 64 * (j))
#define XB_XGEN(j)  (2304 + 64 * (j))
#define XB_TOP      3328
#define XB_TOPGEN   3392
#define XCD_BAR_WORDS 3456
#define XB_SPIN_CAP (1u << 22)
#define LAS __attribute__((address_space(3)))

__device__ __forceinline__ unsigned xb_ld(unsigned* p)              { return __hip_atomic_load(p, __ATOMIC_RELAXED, __HIP_MEMORY_SCOPE_AGENT); }
__device__ __forceinline__ unsigned xb_add(unsigned* p, unsigned v) { return __hip_atomic_fetch_add(p, v, __ATOMIC_RELAXED, __HIP_MEMORY_SCOPE_AGENT); }
__device__ __forceinline__ unsigned xb_xcc_id() { return (unsigned)__builtin_amdgcn_s_getreg((3 << 11) | 20) & 0xFu; }
#define XB_SPIN(cond, bar) do { unsigned _sp = 0; while (cond) { __builtin_amdgcn_s_sleep(1); \
    if ((++_sp & 255u) == 0u) { if (xb_ld(&(bar)[XB_TMO])) break; if (_sp > XB_SPIN_CAP) { atomicAdd(&(bar)[XB_TMO], 1u); break; } } } } while (0)

struct XcdBarrier {
    unsigned* bar; unsigned x;
    volatile LAS unsigned* st;
};

__device__ __forceinline__ XcdBarrier xcd_barrier_post(unsigned* bar, volatile LAS unsigned* st) {
    XcdBarrier b; b.bar = bar; b.x = xb_xcc_id(); b.st = st;
    if (threadIdx.x == 0) (void)xb_add(&bar[XB_XCNT(b.x)], 1u);
    return b;
}
__device__ __forceinline__ void xcd_barrier_complete(unsigned* bar, unsigned x, unsigned& nloc, unsigned& nx) {
    const unsigned G = gridDim.x * gridDim.y * gridDim.z;
    unsigned sum, cnt, mine, sp = 0u;
    for (;;) {
        sum = 0u; cnt = 0u; mine = 0u;
#pragma unroll
        for (unsigned j = 0; j < 16; ++j) { const unsigned c = xb_ld(&bar[XB_XCNT(j)]); sum += c; cnt += (c > 0u) ? 1u : 0u; mine = (j == x) ? c : mine; }
        if (sum == G) break;
        __builtin_amdgcn_s_sleep(1);
        if ((++sp & 255u) == 0u) { if (xb_ld(&bar[XB_TMO])) break; if (sp > XB_SPIN_CAP) { atomicAdd(&bar[XB_TMO], 1u); break; } }
    }
    nloc = mine > 0u ? mine : 1u; nx = cnt > 0u ? cnt : 1u;
}

__device__ __forceinline__ void xcd_barrier(const XcdBarrier& b) {
    asm volatile("s_waitcnt vmcnt(0)" ::: "memory");
    __syncthreads();
    if (threadIdx.x == 0) {
        unsigned* bar = b.bar;
        __builtin_amdgcn_s_waitcnt(0);
        unsigned nloc = b.st[0], nx = b.st[1];
        if (nloc == 0u) { xcd_barrier_complete(bar, b.x, nloc, nx); b.st[0] = nloc; b.st[1] = nx; }
        const unsigned old = xb_add(&bar[XB_XSUB(b.x)], 1u);
        const unsigned gen = old / nloc;
        if (old + 1u == (gen + 1u) * nloc) {
            __builtin_amdgcn_fence(__ATOMIC_RELEASE, "agent");
            asm volatile("s_waitcnt vmcnt(0)" ::: "memory");
            const unsigned og = xb_add(&bar[XB_TOP], 1u);
            const unsigned tg = og / nx;
            if (og + 1u == (tg + 1u) * nx) xb_add(&bar[XB_TOPGEN], 1u);
            else XB_SPIN(xb_ld(&bar[XB_TOPGEN]) == tg, bar);
            __builtin_amdgcn_fence(__ATOMIC_ACQUIRE, "agent");
            xb_add(&bar[XB_XGEN(b.x)], 1u);
            asm volatile("s_waitcnt vmcnt(0)" ::: "memory");
        } else {
            XB_SPIN(xb_ld(&bar[XB_XGEN(b.x)]) == gen, bar);
            __builtin_amdgcn_fence(__ATOMIC_ACQUIRE, "agent");
            asm volatile("s_waitcnt vmcnt(0)" ::: "memory");
        }
    }
    __syncthreads();
}


__device__ __forceinline__ void k_prep_w(unsigned char* lds, const int bid, const int G, const float* __restrict__ W, bf16_t* __restrict__ Wt, int K, int N, int Npad, const float* __restrict__ scale, int period) {
    float (*tile)[65] = (float (*)[65])lds;
    const int ntn = Npad / 64, ntk = K / 64;
    const int tid = opaque_tid(); const int tx = tid & 63, ty = tid >> 6;
    for (int t = bid; t < ntn * ntk; t += G) {
        const int tn = t % ntn, tk = t / ntn;
        __syncthreads();
#pragma unroll
        for (int j = 0; j < 8; ++j) {
            const int k = tk * 64 + ty + j * 8, n = tn * 64 + tx;
            float v = 0.f;
            if (n < N) { v = W[(size_t)k * N + n]; if (scale) v *= scale[k % period]; }
            tile[ty + j * 8][tx] = v;
        }
        __syncthreads();
#pragma unroll
        for (int j = 0; j < 8; ++j) {
            const int n = tn * 64 + ty + j * 8, k = tk * 64 + tx;
            Wt[(size_t)n * K + k] = f2bf(tile[tx][ty + j * 8]);
        }
    }
}

__device__ __forceinline__ void sincos_d(double x, double& s, double& c) {
    const double q = rint(x * 0.63661977236758134308);
    double r = fma(-q, 1.57079632679489655800e+00, x);
    r = fma(-q, 6.12323399573676603587e-17, r);
    const double r2 = r * r;
    double sp = -7.6471637318198164759e-13; sp = fma(sp, r2, 1.6059043836821614599e-10); sp = fma(sp, r2, -2.5052108385441718775e-08);
    sp = fma(sp, r2, 2.7557319223985890653e-06); sp = fma(sp, r2, -1.9841269841269841270e-04); sp = fma(sp, r2, 8.3333333333333333333e-03);
    sp = fma(sp, r2, -1.6666666666666666667e-01); const double sn = fma(sp * r2, r, r);
    double cp = 4.7794773323873852974e-14; cp = fma(cp, r2, -1.1470745597729724714e-11); cp = fma(cp, r2, 2.0876756987868098979e-09);
    cp = fma(cp, r2, -2.7557319223985890653e-07); cp = fma(cp, r2, 2.4801587301587301587e-05); cp = fma(cp, r2, -1.3888888888888888889e-03);
    cp = fma(cp, r2, 4.1666666666666666667e-02); cp = fma(cp, r2, -0.5); const double cs = fma(cp, r2, 1.0);
    const int qi = ((int)q) & 3;
    s = (qi == 0) ? sn : (qi == 1) ? cs : (qi == 2) ? -sn : -cs;
    c = (qi == 0) ? cs : (qi == 1) ? -sn : (qi == 2) ? -cs : sn;
}
__device__ __forceinline__ void k_rope(unsigned char* lds, const int bid, const int G, float* __restrict__ rope) {
    const int tid = opaque_tid();
    for (int idx = bid * NT + tid; idx < (PL + SL) * 128; idx += G * NT) {
    const int p = idx >> 7, i = idx & 127;
    const double pos = (p < PL) ? (double)p : (double)(PAST + p - PL);
    double inv = 1.0, b = 0.93057204092969897; int e = i;
    while (e) { if (e & 1) inv *= b; b *= b; e >>= 1; }
    double s, c; sincos_d(pos * inv, s, c);
    rope[(size_t)idx * 2] = (float)c; rope[(size_t)idx * 2 + 1] = (float)s;
    }
}

__device__ __forceinline__ void k_copy_x(unsigned char* lds, const int bid, const int G, const float* __restrict__ xp, const float* __restrict__ xs, float* __restrict__ xres) {
    const size_t n4p = (size_t)TP * D / 4, n4 = (size_t)T * D / 4;
    const int tid = opaque_tid();
    for (size_t i = (size_t)bid * NT + tid; i < n4; i += (size_t)G * NT) {
        const float4 v = (i < n4p) ? ((const float4*)xp)[i] : ((const float4*)xs)[i - n4p];
        ((float4*)xres)[i] = v;
    }
}

__device__ __forceinline__ void k_norm_prep(unsigned char* lds, const int bid, const int G, const float* __restrict__ xres, bf16_t* __restrict__ xb) {
    float* red = (float*)lds;
    const int tid = opaque_tid();
    for (int row = bid; row < T; row += G) {
        const float2 v = ((const float2*)(xres + (size_t)row * D))[tid];
        float ss = wave_sum(v.x * v.x + v.y * v.y);
        __syncthreads();
        if ((tid & 63) == 0) red[tid >> 6] = ss;
        __syncthreads();
        float tot = 0.f;
#pragma unroll
        for (int i = 0; i < 8; ++i) tot += red[i];
        const float rs = rsqrtf(tot * (1.f / D) + EPS);
        const uint32_t pk = (uint32_t)f2bf(v.x * rs) | ((uint32_t)f2bf(v.y * rs) << 16);
        ((uint32_t*)(xb + (size_t)row * D))[tid] = pk;
    }
}

__device__ __forceinline__ void k_final_norm(unsigned char* lds, const int bid, const int G, const float* __restrict__ xres, const float* __restrict__ w, float* __restrict__ out) {
    float* red = (float*)lds;
    const int tid = opaque_tid();
    for (int row = bid; row < T; row += G) {
        const float2 v = ((const float2*)(xres + (size_t)row * D))[tid];
        float ss = wave_sum(v.x * v.x + v.y * v.y);
        __syncthreads();
        if ((tid & 63) == 0) red[tid >> 6] = ss;
        __syncthreads();
        float tot = 0.f;
#pragma unroll
        for (int i = 0; i < 8; ++i) tot += red[i];
        const float rs = rsqrtf(tot * (1.f / D) + EPS);
        const float2 wv = ((const float2*)w)[tid];
        float2 o; o.x = v.x * rs * wv.x; o.y = v.y * rs * wv.y;
        ((float2*)(out + (size_t)row * D))[tid] = o;
    }
}

template <int KIND>
__device__ __forceinline__ void k_gate(unsigned char* lds, const int bid, const int G, const float* __restrict__ ymix, const bf16_t* __restrict__ proj, bf16_t* __restrict__ ab) {
    float* red = (float*)lds;
    const int tid = opaque_tid(), e = tid * 4;
    for (int row = bid; row < T; row += G) {
        const float4 y = *(const float4*)(ymix + (size_t)row * 2048 + e);
        const int gcol = (KIND == 0) ? 4096 + e : (KIND == 1) ? e : 4096 + e;
        const uint2 graw = *(const uint2*)(proj + (size_t)row * NIN + gcol);
        float g[4] = { bf2f((bf16_t)(graw.x & 0xffff)), bf2f((bf16_t)(graw.x >> 16)), bf2f((bf16_t)(graw.y & 0xffff)), bf2f((bf16_t)(graw.y >> 16)) };
        float v[4] = { y.x, y.y, y.z, y.w };
        float o[4];
        if (KIND == 0) {
            float ss = wave_sum(v[0] * v[0] + v[1] * v[1] + v[2] * v[2] + v[3] * v[3]);
            __syncthreads();
            if ((tid & 63) == 0) red[tid >> 6] = ss;
            __syncthreads();
            const int h = tid >> 7;
            const float rs = rsqrtf((red[2 * h] + red[2 * h + 1]) * (1.f / 512.f) + EPS);
#pragma unroll
            for (int j = 0; j < 4; ++j) o[j] = silu_f(g[j]) * v[j] * rs;
        } else if (KIND == 1) {
#pragma unroll
            for (int j = 0; j < 4; ++j) v[j] *= silu_f(g[j]);
            const float ss = wave_sum(v[0] * v[0] + v[1] * v[1] + v[2] * v[2] + v[3] * v[3]);
            const float rs = rsqrtf(ss * (1.f / 256.f) + EPS);
#pragma unroll
            for (int j = 0; j < 4; ++j) o[j] = v[j] * rs;
        } else {
            float ss = v[0] * v[0] + v[1] * v[1] + v[2] * v[2] + v[3] * v[3];
#pragma unroll
            for (int of = 16; of > 0; of >>= 1) ss += __shfl_xor(ss, of);
            const float rs = rsqrtf(ss * (1.f / 128.f) + EPS);
#pragma unroll
            for (int j = 0; j < 4; ++j) o[j] = v[j] * rs * silu_f(g[j]);
        }
        uint2 pk; pk.x = (uint32_t)f2bf(o[0]) | ((uint32_t)f2bf(o[1]) << 16); pk.y = (uint32_t)f2bf(o[2]) | ((uint32_t)f2bf(o[3]) << 16);
        *(uint2*)(ab + (size_t)row * 2048 + e) = pk;
    }
}

template <int MODE>
__device__ __forceinline__ void k_conv_pre(unsigned char* lds, const int bid, const int G, const bf16_t* __restrict__ proj, const float* __restrict__ cstate, const float* __restrict__ cw, const float* __restrict__ cb,
                                                 const float* __restrict__ dt_bias, const float* __restrict__ a_log,
                                                 float* __restrict__ act, float* __restrict__ sm1, float* __restrict__ sm2,
                                                 float* __restrict__ pconv, float* __restrict__ sconv) {
    float* buf = (float*)lds;
    const int tid = opaque_tid();
    const int c0 = (MODE == 1) ? 2048 : 0;
    for (int row = bid; row < T; row += G) {
        int t, L, b; bool samp;
        if (row < TP) { b = row / PL; t = row % PL; L = PL; samp = false; } else { b = (row - TP) / SL; t = (row - TP) % SL; L = SL; samp = true; }
        __syncthreads();
        for (int c = tid; c < 4096; c += NT) {
            float acc = (MODE == 1) ? cb[c] : 0.f;
#pragma unroll
            for (int tap = 0; tap < 4; ++tap) {
                const int i = t + tap;
                float val;
                if (i < 3) val = samp ? cstate[((size_t)b * 3 + i) * 4096 + c] : 0.f;
                else val = bf2f(proj[(size_t)(row - t + i - 3) * NIN + c0 + c]);
                acc += val * cw[tap * 4096 + c];
            }
            const float a = silu_f(acc);
            if (MODE == 1) act[(size_t)row * 4096 + c] = a; else buf[c] = a;
            if (t >= L - 3) {
                const float raw = bf2f(proj[(size_t)row * NIN + c0 + c]);
                float* dst = samp ? sconv : pconv;
                dst[((size_t)b * 3 + (t - (L - 3))) * 4096 + c] = raw;
            }
        }
        if (MODE == 1) {
            if (tid < 32) sm1[(size_t)row * 32 + tid] = softplus_f(bf2f(proj[(size_t)row * NIN + 6144 + tid]) + dt_bias[tid]);
        } else {
            if (tid < 16) {
                sm1[(size_t)row * 16 + tid] = sigmoid_f(bf2f(proj[(size_t)row * NIN + 6144 + tid]));
                sm2[(size_t)row * 16 + tid] = -__expf(a_log[tid]) * softplus_f(bf2f(proj[(size_t)row * NIN + 6160 + tid]) + dt_bias[tid]);
            }
            __syncthreads();
            const int w = tid >> 6, lane = tid & 63;
#pragma unroll
            for (int hh = 0; hh < 2; ++hh) {
                const int head = w * 2 + hh;
                const float2 v = *(const float2*)(buf + head * 128 + lane * 2);
                const float ss = wave_sum(v.x * v.x + v.y * v.y);
                const float sc = rsqrtf(ss + EPS) * ((head < 8) ? 0.08838834764831845f : 1.f);
                float2 o; o.x = v.x * sc; o.y = v.y * sc;
                *(float2*)(act + (size_t)row * 4096 + head * 128 + lane * 2) = o;
            }
            for (int c = 2048 + tid; c < 4096; c += NT) act[(size_t)row * 4096 + c] = buf[c];
        }
    }
}

__device__ __forceinline__ void k_ret_scan(unsigned char* lds, const int bid, const int G, const bf16_t* __restrict__ proj, const float* __restrict__ rope, const float* __restrict__ s_in  ,
                                                 float* __restrict__ ymix, float* __restrict__ p_out, float* __restrict__ s_out) {
    float (*qs)[256] = (float (*)[256])lds; float (*ks)[256] = (float (*)[256])(lds + 4096); float (*vs)[64] = (float (*)[64])(lds + 8192); float (*red)[4][64] = (float (*)[4][64])(lds + 9216);
    const int tid = opaque_tid(), lane = tid & 63, wv = tid >> 6, c4 = tid & 15, dg = tid >> 4;
    for (int unit = bid; unit < NSEQ * 32; unit += G) {
        const int s = unit >> 5, h = (unit >> 3) & 3, sl = unit & 7;
        int tok0, L, prow0; seq_info(s, tok0, L, prow0);
        const float gamma = 1.f - exp2f(-5.f - (float)h);
        const size_t st_off = (((size_t)(s < NPB ? s : s - NPB) * 4 + h) * 256) * 512 + sl * 64 + c4 * 4;
        float S[8][4];
#pragma unroll
        for (int r = 0; r < 8; ++r) {
            float4 v = make_float4(0.f, 0.f, 0.f, 0.f);
            if (s >= NPB) v = *(const float4*)(s_in + st_off + (size_t)(dg * 8 + r) * 512);
            S[r][0] = v.x; S[r][1] = v.y; S[r][2] = v.z; S[r][3] = v.w;
        }
        for (int t0 = 0; t0 < L; t0 += 4) {
            __syncthreads();
            {
                const int tt = tid >> 7, i = tid & 127;
                const size_t rb = (size_t)(tok0 + t0 + tt) * NIN;
                const float2 cs = *(const float2*)(rope + ((size_t)(prow0 + t0 + tt) * 128 + i) * 2);
                const float q1 = bf2f(proj[rb + h * 256 + i]), q2 = bf2f(proj[rb + h * 256 + 128 + i]);
                const float k1 = bf2f(proj[rb + 1024 + h * 256 + i]), k2 = bf2f(proj[rb + 1024 + h * 256 + 128 + i]);
                qs[tt][i] = q1 * cs.x - q2 * cs.y; qs[tt][i + 128] = q1 * cs.y + q2 * cs.x;
                ks[tt][i] = (k1 * cs.x - k2 * cs.y) * 0.0625f; ks[tt][i + 128] = (k1 * cs.y + k2 * cs.x) * 0.0625f;
                if (tid < 256) { const int t2 = tid >> 6, c = tid & 63; vs[t2][c] = bf2f(proj[(size_t)(tok0 + t0 + t2) * NIN + 2048 + h * 512 + sl * 64 + c]); }
            }
            __syncthreads();
#pragma unroll 1
            for (int tt = 0; tt < 4; ++tt) {
                const float4 vv = *(const float4*)(&vs[tt][c4 * 4]);
                const float vvv[4] = { vv.x, vv.y, vv.z, vv.w };
                float yp[4] = { 0.f, 0.f, 0.f, 0.f };
#pragma unroll
                for (int r = 0; r < 8; ++r) {
                    const float kk = ks[tt][dg * 8 + r], qq = qs[tt][dg * 8 + r];
#pragma unroll
                    for (int j = 0; j < 4; ++j) { S[r][j] = gamma * S[r][j] + kk * vvv[j]; yp[j] += qq * S[r][j]; }
                }
#pragma unroll
                for (int j = 0; j < 4; ++j) { float v = yp[j]; v += __shfl_xor(v, 16); v += __shfl_xor(v, 32); yp[j] = v; }
                if (lane < 16) *(float4*)(&red[wv][tt][c4 * 4]) = make_float4(yp[0], yp[1], yp[2], yp[3]);
            }
            __syncthreads();
            if (tid < 256) {
                const int tt = tid >> 6, c = tid & 63; float a = 0.f;
#pragma unroll
                for (int w = 0; w < 8; ++w) a += red[w][tt][c];
                ymix[(size_t)(tok0 + t0 + tt) * 2048 + h * 512 + sl * 64 + c] = a;
            }
        }
        float* so = (s < NPB) ? p_out : s_out;
#pragma unroll
        for (int r = 0; r < 8; ++r) *(float4*)(so + st_off + (size_t)(dg * 8 + r) * 512) = make_float4(S[r][0], S[r][1], S[r][2], S[r][3]);
    }
}

__device__ __forceinline__ void k_ssd_scan(unsigned char* lds, const int bid, const int G, const float* __restrict__ act, const float* __restrict__ dtv, const float* __restrict__ a_log, const float* __restrict__ dskip,
                                                 const float* __restrict__ s_in  , float* __restrict__ ymix, float* __restrict__ p_out, float* __restrict__ s_out) {
    float (*xs)[64] = (float (*)[64])lds; float (*Bs)[128] = (float (*)[128])(lds + 1024); float (*Cs)[128] = (float (*)[128])(lds + 3072); float* dts = (float*)(lds + 5120);
    const int tid = opaque_tid(), n4 = tid & 31, pg = tid >> 5;
    for (int unit = bid; unit < NSEQ * 32; unit += G) {
        const int s = unit >> 5, hh = unit & 31, g = hh >> 2;
        int tok0, L, prow0; seq_info(s, tok0, L, prow0);
        const float A = -__expf(a_log[hh]), Dk = dskip[hh];
        const size_t st_off = (((size_t)(s < NPB ? s : s - NPB) * 32 + hh) * 64) * 128 + n4 * 4;
        float S[4][4];
#pragma unroll
        for (int r = 0; r < 4; ++r) {
            float4 v = make_float4(0.f, 0.f, 0.f, 0.f);
            if (s >= NPB) v = *(const float4*)(s_in + st_off + (size_t)(pg * 4 + r) * 128);
            S[r][0] = v.x; S[r][1] = v.y; S[r][2] = v.z; S[r][3] = v.w;
        }
        for (int t0 = 0; t0 < L; t0 += 4) {
            __syncthreads();
            {
                const int tt = tid >> 7, i = tid & 127;
                const size_t rb = (size_t)(tok0 + t0 + tt) * 4096;
                Bs[tt][i] = act[rb + 2048 + g * 128 + i];
                Cs[tt][i] = act[rb + 3072 + g * 128 + i];
                if (i < 64) xs[tt][i] = act[rb + hh * 64 + i];
                if (i == 64) dts[tt] = dtv[(size_t)(tok0 + t0 + tt) * 32 + hh];
            }
            __syncthreads();
#pragma unroll
            for (int tt = 0; tt < 4; ++tt) {
                const float dt = dts[tt], a = __expf(dt * A);
                const float4 bv = *(const float4*)(&Bs[tt][n4 * 4]), cv = *(const float4*)(&Cs[tt][n4 * 4]);
                const float bb[4] = { bv.x, bv.y, bv.z, bv.w }, cc[4] = { cv.x, cv.y, cv.z, cv.w };
                float yp[4];
#pragma unroll
                for (int r = 0; r < 4; ++r) {
                    const float xv = xs[tt][pg * 4 + r], xd = xv * dt;
                    float acc = 0.f;
#pragma unroll
                    for (int j = 0; j < 4; ++j) { S[r][j] = a * S[r][j] + xd * bb[j]; acc += S[r][j] * cc[j]; }
#pragma unroll
                    for (int of = 16; of > 0; of >>= 1) acc += __shfl_xor(acc, of);
                    yp[r] = acc + Dk * xv;
                }
                if (n4 == 0) *(float4*)(ymix + (size_t)(tok0 + t0 + tt) * 2048 + hh * 64 + pg * 4) = make_float4(yp[0], yp[1], yp[2], yp[3]);
            }
        }
        float* so = (s < NPB) ? p_out : s_out;
#pragma unroll
        for (int r = 0; r < 4; ++r) *(float4*)(so + st_off + (size_t)(pg * 4 + r) * 128) = make_float4(S[r][0], S[r][1], S[r][2], S[r][3]);
    }
}

__device__ __forceinline__ void k_gdn_scan(unsigned char* lds, const int bid, const int G, const float* __restrict__ act, const float* __restrict__ betav, const float* __restrict__ gv,
                                                 const float* __restrict__ s_in  , float* __restrict__ ymix, float* __restrict__ p_out, float* __restrict__ s_out) {
    float (*qs)[128] = (float (*)[128])lds; float (*ks)[128] = (float (*)[128])(lds + 2048); float (*vs)[128] = (float (*)[128])(lds + 4096); float* gs = (float*)(lds + 6144); float* bs = (float*)(lds + 6160);
    float (*red)[8][128] = (float (*)[8][128])(lds + 6400); float (*ored)[4][128] = (float (*)[4][128])(lds + 6400 + 8192);
    const int tid = opaque_tid(), lane = tid & 63, wv = tid >> 6, v4 = tid & 31, kg = tid >> 5;
    for (int unit = bid; unit < NSEQ * 16; unit += G) {
        const int s = unit >> 4, hv = unit & 15, hk = hv >> 1;
        int tok0, L, prow0; seq_info(s, tok0, L, prow0);
        const size_t st_off = (((size_t)(s < NPB ? s : s - NPB) * 16 + hv) * 128) * 128 + v4 * 4;
        float S[8][4];
#pragma unroll
        for (int r = 0; r < 8; ++r) {
            float4 v = make_float4(0.f, 0.f, 0.f, 0.f);
            if (s >= NPB) v = *(const float4*)(s_in + st_off + (size_t)(kg * 8 + r) * 128);
            S[r][0] = v.x; S[r][1] = v.y; S[r][2] = v.z; S[r][3] = v.w;
        }
        for (int t0 = 0; t0 < L; t0 += 4) {
            __syncthreads();
            {
                const int tt = tid >> 7, i = tid & 127;
                const size_t rb = (size_t)(tok0 + t0 + tt) * 4096;
                qs[tt][i] = act[rb + hk * 128 + i];
                ks[tt][i] = act[rb + 1024 + hk * 128 + i];
                vs[tt][i] = act[rb + 2048 + hv * 128 + i];
                if (i == 0) { gs[tt] = gv[(size_t)(tok0 + t0 + tt) * 16 + hv]; bs[tt] = betav[(size_t)(tok0 + t0 + tt) * 16 + hv]; }
            }
            __syncthreads();
#pragma unroll 1
            for (int tt = 0; tt < 4; ++tt) {
                const float eg = __expf(gs[tt]), beta = bs[tt];
                float kr[8], part[4] = { 0.f, 0.f, 0.f, 0.f };
#pragma unroll
                for (int r = 0; r < 8; ++r) {
                    kr[r] = ks[tt][kg * 8 + r];
#pragma unroll
                    for (int j = 0; j < 4; ++j) { S[r][j] *= eg; part[j] += S[r][j] * kr[r]; }
                }
#pragma unroll
                for (int j = 0; j < 4; ++j) part[j] += __shfl_xor(part[j], 32);
                if (lane < 32) *(float4*)(&red[tt & 1][wv][v4 * 4]) = make_float4(part[0], part[1], part[2], part[3]);
                __syncthreads();
                float kS[4] = { 0.f, 0.f, 0.f, 0.f };
#pragma unroll
                for (int w = 0; w < 8; ++w) { const float4 pv = *(const float4*)(&red[tt & 1][w][v4 * 4]); kS[0] += pv.x; kS[1] += pv.y; kS[2] += pv.z; kS[3] += pv.w; }
                const float4 vv = *(const float4*)(&vs[tt][v4 * 4]);
                const float dl[4] = { beta * (vv.x - kS[0]), beta * (vv.y - kS[1]), beta * (vv.z - kS[2]), beta * (vv.w - kS[3]) };
                float op[4] = { 0.f, 0.f, 0.f, 0.f };
#pragma unroll
                for (int r = 0; r < 8; ++r) {
                    const float qq = qs[tt][kg * 8 + r];
#pragma unroll
                    for (int j = 0; j < 4; ++j) { S[r][j] += kr[r] * dl[j]; op[j] += S[r][j] * qq; }
                }
#pragma unroll
                for (int j = 0; j < 4; ++j) op[j] += __shfl_xor(op[j], 32);
                if (lane < 32) *(float4*)(&ored[wv][tt][v4 * 4]) = make_float4(op[0], op[1], op[2], op[3]);
            }
            __syncthreads();
            {
                const int tt = tid >> 7, c = tid & 127; float a = 0.f;
#pragma unroll
                for (int w = 0; w < 8; ++w) a += ored[w][tt][c];
                ymix[(size_t)(tok0 + t0 + tt) * 2048 + hv * 128 + c] = a;
            }
        }
        float* so = (s < NPB) ? p_out : s_out;
#pragma unroll
        for (int r = 0; r < 8; ++r) *(float4*)(so + st_off + (size_t)(kg * 8 + r) * 128) = make_float4(S[r][0], S[r][1], S[r][2], S[r][3]);
    }
}

template <int EPI>
__device__ __forceinline__ void k_gemm(unsigned char* lds, const int bid, const int G, const bf16_t* __restrict__ A, const bf16_t* __restrict__ Bt, int M, int N, int K, bf16_t* __restrict__ Cb, const float* __restrict__ Cin, float* __restrict__ Cf, int ldc) {
    float (*As)[132] = (float (*)[132])lds; float (*Bs)[132] = (float (*)[132])(lds + 8448);
    const int tid = opaque_tid(), tx = tid & 31, ty = tid >> 5;
    const int ntm = M / 128, ntn = N / 128;
    for (int tile = bid; tile < ntm * ntn; tile += G) {
        const int m0 = (tile / ntn) * 128, n0 = (tile % ntn) * 128;
        float acc[8][4];
#pragma unroll
        for (int i = 0; i < 8; ++i)
#pragma unroll
            for (int j = 0; j < 4; ++j) acc[i][j] = 0.f;
        const int lr = tid >> 2, lk = (tid & 3) * 4;
        for (int k0 = 0; k0 < K; k0 += 16) {
            const uint2 av = *(const uint2*)(A + (size_t)(m0 + lr) * K + k0 + lk);
            const uint2 bv = *(const uint2*)(Bt + (size_t)(n0 + lr) * K + k0 + lk);
            __syncthreads();
            As[lk + 0][lr] = bf2f((bf16_t)(av.x & 0xffff)); As[lk + 1][lr] = bf2f((bf16_t)(av.x >> 16)); As[lk + 2][lr] = bf2f((bf16_t)(av.y & 0xffff)); As[lk + 3][lr] = bf2f((bf16_t)(av.y >> 16));
            Bs[lk + 0][lr] = bf2f((bf16_t)(bv.x & 0xffff)); Bs[lk + 1][lr] = bf2f((bf16_t)(bv.x >> 16)); Bs[lk + 2][lr] = bf2f((bf16_t)(bv.y & 0xffff)); Bs[lk + 3][lr] = bf2f((bf16_t)(bv.y >> 16));
            __syncthreads();
#pragma unroll
            for (int k = 0; k < 16; ++k) {
                const float4 a0 = *(const float4*)(&As[k][ty * 8]), a1 = *(const float4*)(&As[k][ty * 8 + 4]), b = *(const float4*)(&Bs[k][tx * 4]);
                const float a[8] = { a0.x, a0.y, a0.z, a0.w, a1.x, a1.y, a1.z, a1.w }, bb[4] = { b.x, b.y, b.z, b.w };
#pragma unroll
                for (int i = 0; i < 8; ++i)
#pragma unroll
                    for (int j = 0; j < 4; ++j) acc[i][j] += a[i] * bb[j];
            }
        }
#pragma unroll
        for (int i = 0; i < 8; ++i) {
            const int m = m0 + ty * 8 + i, n = n0 + tx * 4;
            if (EPI == 2) {
                float4 o = *(const float4*)(Cin + (size_t)m * ldc + n);
                o.x += acc[i][0]; o.y += acc[i][1]; o.z += acc[i][2]; o.w += acc[i][3]; *(float4*)(Cf + (size_t)m * ldc + n) = o;
            } else {
                float v[4] = { acc[i][0], acc[i][1], acc[i][2], acc[i][3] };
                if (EPI == 1) {
#pragma unroll
                    for (int j = 0; j < 4; ++j) { const float r = fmaxf(v[j], 0.f); v[j] = r * r; }
                }
                uint2 pk; pk.x = (uint32_t)f2bf(v[0]) | ((uint32_t)f2bf(v[1]) << 16); pk.y = (uint32_t)f2bf(v[2]) | ((uint32_t)f2bf(v[3]) << 16);
                *(uint2*)(Cb + (size_t)m * ldc + n) = pk;
            }
        }
    }
}


constexpr int LDS_BYTES = 65536;

#define GRID_BAR() xcd_barrier(xbar)

template <int L>
__device__ __forceinline__ void layer_body(const P& p, unsigned char* lds, const int bid, const int G, const XcdBarrier& xbar) {
    constexpr int kind = L % 3, j = L / 3;
    k_gemm<0>(lds, bid, G, p.xb, p.w_in[L], T, NIN, D, p.proj, nullptr, nullptr, NIN);
    GRID_BAR();
    if (kind == 0) {
        k_ret_scan(lds, bid, G, p.proj, p.rope, p.in[2] + (size_t)j * NSB * RET_ST, p.ymix,
                   p.out + O_PRET + (size_t)j * NPB * RET_ST, p.out + O_SRET + (size_t)j * NSB * RET_ST);
        GRID_BAR();
        k_gate<0>(lds, bid, G, p.ymix, p.proj, p.ab);
    } else if (kind == 1) {
        k_conv_pre<1>(lds, bid, G, p.proj, p.in[4], p.in[13], p.in[14], p.in[15], p.in[16], p.act, p.sm1, p.sm2, p.out + O_PSSDC, p.out + O_SSSDC);
        GRID_BAR();
        k_ssd_scan(lds, bid, G, p.act, p.sm1, p.in[16], p.in[17], p.in[3], p.ymix, p.out + O_PSSD, p.out + O_SSSD);
        GRID_BAR();
        k_gate<1>(lds, bid, G, p.ymix, p.proj, p.ab);
    } else {
        k_conv_pre<2>(lds, bid, G, p.proj, p.in[6], p.in[21], nullptr, p.in[22], p.in[23], p.act, p.sm1, p.sm2, p.out + O_PGDNC, p.out + O_SGDNC);
        GRID_BAR();
        k_gdn_scan(lds, bid, G, p.act, p.sm1, p.sm2, p.in[5], p.ymix, p.out + O_PGDN, p.out + O_SGDN);
        GRID_BAR();
        k_gate<2>(lds, bid, G, p.ymix, p.proj, p.ab);
    }
    GRID_BAR();
    k_gemm<2>(lds, bid, G, p.ab, p.w_out[L], T, D, 2048, nullptr, p.xres, p.xres2, D);
    GRID_BAR();
    k_norm_prep(lds, bid, G, p.xres2, p.xb);
    GRID_BAR();
    k_gemm<1>(lds, bid, G, p.xb, p.w_up[L], T, DFF, D, p.u, nullptr, nullptr, DFF);
    GRID_BAR();
    k_gemm<2>(lds, bid, G, p.u, p.w_dn[L], T, D, DFF, nullptr, p.xres2, p.xres, D);
    GRID_BAR();
    if (L < 3) { k_norm_prep(lds, bid, G, p.xres, p.xb); GRID_BAR(); }
}

__global__ void __launch_bounds__(NT, 2) mega_fwd(const P p) {
    extern __shared__ __attribute__((aligned(16))) unsigned char lds[];
    const int bid = blockIdx.x, G = gridDim.x;
    LAS unsigned* stw = (LAS unsigned*)(lds + LDS_BYTES - 16);
    if (threadIdx.x < 4) stw[threadIdx.x] = 0u;
    __syncthreads();
    const XcdBarrier xbar = xcd_barrier_post(p.bar, (volatile LAS unsigned*)stw);
    const float* norm_mix = p.in[7]; const float* norm_mlp = p.in[8];
#pragma unroll
    for (int l = 0; l < 4; ++l) {
        const int kind = l % 3, j = l / 3;
        if (kind == 0) {
            k_prep_w(lds, bid, G, p.in[10] + (size_t)j * D * 6144, p.w_in[l], D, 6144, NIN, norm_mix + l * D, D);
            k_prep_w(lds, bid, G, p.in[11] + (size_t)j * 2048 * D, p.w_out[l], 2048, D, D, nullptr, 1);
        } else if (kind == 1) {
            k_prep_w(lds, bid, G, p.in[12], p.w_in[l], D, 6176, NIN, norm_mix + l * D, D);
            k_prep_w(lds, bid, G, p.in[19], p.w_out[l], 2048, D, D, p.in[18], 2048);
        } else {
            k_prep_w(lds, bid, G, p.in[20], p.w_in[l], D, 6176, NIN, norm_mix + l * D, D);
            k_prep_w(lds, bid, G, p.in[25], p.w_out[l], 2048, D, D, p.in[24], 128);
        }
        k_prep_w(lds, bid, G, p.in[26] + (size_t)l * D * DFF, p.w_up[l], D, DFF, DFF, norm_mlp + l * D, D);
        k_prep_w(lds, bid, G, p.in[27] + (size_t)l * DFF * D, p.w_dn[l], DFF, D, D, nullptr, 1);
    }
    k_rope(lds, bid, G, p.rope);
    k_copy_x(lds, bid, G, p.in[0], p.in[1], p.xres);
    GRID_BAR();
    k_norm_prep(lds, bid, G, p.xres, p.xb);
    GRID_BAR();
    layer_body<0>(p, lds, bid, G, xbar);
    layer_body<1>(p, lds, bid, G, xbar);
    layer_body<2>(p, lds, bid, G, xbar);
    layer_body<3>(p, lds, bid, G, xbar);
    k_final_norm(lds, bid, G, p.xres, p.in[9], p.out);
}

static inline size_t al256(size_t x) { return (x + 255) & ~(size_t)255; }

extern "C" void kernel_launch(void* const* d_in, const int* in_sizes, int n_in, void* d_out, int out_size, void* d_ws, size_t ws_size, hipStream_t stream) {
    static int grid = 0;
    if (grid == 0) {
        int dev = 0, cus = 0, per_cu = 0;
        hipGetDevice(&dev);
        hipDeviceGetAttribute(&cus, hipDeviceAttributeMultiprocessorCount, dev);
        hipFuncSetAttribute((const void*)mega_fwd, hipFuncAttributeMaxDynamicSharedMemorySize, LDS_BYTES);
        hipOccupancyMaxActiveBlocksPerMultiprocessor(&per_cu, (const void*)mega_fwd, NT, LDS_BYTES);
        (void)hipGetLastError();
        if (cus <= 0) cus = 256;
        grid = cus;
    }
    P p{};
    for (int i = 0; i < 28; ++i) p.in[i] = (const float*)d_in[i];
    p.out = (float*)d_out;
    char* w = (char*)d_ws; size_t off = 65536;
    p.bar = (unsigned*)d_ws;
    auto take = [&](size_t bytes) { char* r = w + off; off = al256(off + bytes); return r; };
    p.xres = (float*)take((size_t)T * D * 4);
    p.xres2 = (float*)take((size_t)T * D * 4);
    p.xb = (bf16_t*)take((size_t)T * D * 2);
    p.proj = (bf16_t*)take((size_t)T * NIN * 2);
    p.act = (float*)take((size_t)T * 4096 * 4);
    p.sm1 = (float*)take((size_t)T * 32 * 4);
    p.sm2 = (float*)take((size_t)T * 32 * 4);
    p.ymix = (float*)take((size_t)T * 2048 * 4);
    p.ab = (bf16_t*)take((size_t)T * 2048 * 2);
    p.u = (bf16_t*)take((size_t)T * DFF * 2);
    p.rope = (float*)take((size_t)(PL + SL) * 128 * 2 * 4);
    for (int l = 0; l < 4; ++l) {
        p.w_in[l] = (bf16_t*)take((size_t)NIN * D * 2);
        p.w_out[l] = (bf16_t*)take((size_t)D * 2048 * 2);
        p.w_up[l] = (bf16_t*)take((size_t)DFF * D * 2);
        p.w_dn[l] = (bf16_t*)take((size_t)D * DFF * 2);
    }
    hipMemsetAsync(d_ws, 0, 16384, stream);
    hipLaunchKernelGGL(mega_fwd, dim3(grid), dim3(NT), LDS_BYTES, stream, p);
}
```

```cpp
#include <hip/hip_runtime.h>
#include <stdint.h>

typedef uint16_t bf16_t;

#define REP_GEMM 1
#define REP_CHUNK 1
#define REP_SAMP 1
#define REP_ELEM 1
#define REP_P0 1
#define REP_BAR 1
#define REPEAT(n) _Pragma("unroll 1") for (int rep_ = 0; rep_ < (n); ++rep_)

constexpr int D = 1024;
constexpr int NPB = 8, PL = 2048, NSB = 128, SL = 4;
constexpr int TP = NPB * PL, TS = NSB * SL, T = TP + TS;
constexpr int NSEQ = NPB + NSB;
constexpr int PAST = 16384;
constexpr int NIN = 6400;
constexpr int DFF = 4096;
constexpr int NT = 512;
constexpr float EPS = 1e-6f;

constexpr size_t O_YP = 0;
constexpr size_t O_YS = O_YP + (size_t)TP * D;
constexpr size_t O_PRET = O_YS + (size_t)TS * D;
constexpr size_t RET_ST = (size_t)4 * 256 * 512;
constexpr size_t O_PSSD = O_PRET + 2 * NPB * RET_ST;
constexpr size_t SSD_ST = (size_t)32 * 64 * 128;
constexpr size_t O_PSSDC = O_PSSD + NPB * SSD_ST;
constexpr size_t CONV_ST = (size_t)3 * 4096;
constexpr size_t O_PGDN = O_PSSDC + NPB * CONV_ST;
constexpr size_t GDN_ST = (size_t)16 * 128 * 128;
constexpr size_t O_PGDNC = O_PGDN + NPB * GDN_ST;
constexpr size_t O_SRET = O_PGDNC + NPB * CONV_ST;
constexpr size_t O_SSSD = O_SRET + 2 * NSB * RET_ST;
constexpr size_t O_SSSDC = O_SSSD + NSB * SSD_ST;
constexpr size_t O_SGDN = O_SSSDC + NSB * CONV_ST;
constexpr size_t O_SGDNC = O_SGDN + NSB * GDN_ST;
constexpr size_t O_END = O_SGDNC + NSB * CONV_ST;

struct P {
    const float* in[28];
    float* out; unsigned* bar; float* ssq;
    float* xres; float* xres2; bf16_t* xb; bf16_t* proj; bf16_t* act; float* sm1; float* sm2; float* ymix; bf16_t* ab; bf16_t* u; float* rope;
    bf16_t* w_in[4]; bf16_t* w_out[4]; bf16_t* w_up[4]; bf16_t* w_dn[4];
    bf16_t* gU; bf16_t* gW; bf16_t* gQd; bf16_t* gKdT; bf16_t* gAt;
};

__device__ __forceinline__ float bf2f(bf16_t b) { return __uint_as_float(((uint32_t)b) << 16); }
__device__ __forceinline__ bf16_t f2bf(float f) { uint32_t r; asm("v_cvt_pk_bf16_f32 %0, %1, 0" : "=v"(r) : "v"(f)); return (bf16_t)r; }
__device__ __forceinline__ uint32_t pack_bf2(float a, float b) { uint32_t r; asm("v_cvt_pk_bf16_f32 %0, %1, %2" : "=v"(r) : "v"(a), "v"(b)); return r; }
typedef float nt_f4 __attribute__((ext_vector_type(4)));
typedef unsigned nt_u4 __attribute__((ext_vector_type(4)));
typedef unsigned nt_u2 __attribute__((ext_vector_type(2)));
__device__ __forceinline__ uint4 ld_nt_u4(const void* p) { const nt_u4 v = __builtin_nontemporal_load((const nt_u4*)p); return make_uint4(v[0], v[1], v[2], v[3]); }
__device__ __forceinline__ uint2 ld_nt_u2(const void* p) { const nt_u2 v = __builtin_nontemporal_load((const nt_u2*)p); return make_uint2(v[0], v[1]); }
__device__ __forceinline__ float4 ld_nt4(const float* p) { const nt_f4 v = __builtin_nontemporal_load((const nt_f4*)p); return make_float4(v[0], v[1], v[2], v[3]); }
__device__ __forceinline__ void st_nt4(float* p, float a, float b, float c, float d) { const nt_f4 t = {a, b, c, d}; __builtin_nontemporal_store(t, (nt_f4*)p); }
__device__ __forceinline__ float silu_f(float x) { return x * __builtin_amdgcn_rcpf(1.f + __expf(-x)); }
__device__ __forceinline__ float sigmoid_f(float x) { return __builtin_amdgcn_rcpf(1.f + __expf(-x)); }
__device__ __forceinline__ float softplus_f(float x) { const float e = __expf(-fabsf(x)); return fmaxf(x, 0.f) + ((e < 1e-3f) ? e * (1.f - 0.5f * e) : __logf(1.f + e)); }

__device__ __forceinline__ int xcd_unit(int u, int G) { return (G == 256) ? ((u & 7) * 32 + (u >> 3)) : u; }

__device__ __forceinline__ int opaque_tid() { int t = threadIdx.x; asm volatile("" : "+v"(t)); return t; }

__device__ __forceinline__ float row16_sum(float v) {
    v += __builtin_bit_cast(float, __builtin_amdgcn_update_dpp(0, __builtin_bit_cast(int, v), 0x128, 0xF, 0xF, false));
    v += __builtin_bit_cast(float, __builtin_amdgcn_update_dpp(0, __builtin_bit_cast(int, v), 0x124, 0xF, 0xF, false));
    v += __builtin_bit_cast(float, __builtin_amdgcn_update_dpp(0, __builtin_bit_cast(int, v), 0x122, 0xF, 0xF, false));
    v += __builtin_bit_cast(float, __builtin_amdgcn_update_dpp(0, __builtin_bit_cast(int, v), 0x121, 0xF, 0xF, false));
    return v;
}

__device__ __forceinline__ float wave_sum(float v) { v = row16_sum(v); v += __shfl_xor(v, 16); v += __shfl_xor(v, 32); return v; }
__device__ __forceinline__ float half_sum(float v) { v = row16_sum(v); v += __shfl_xor(v, 16); return v; }

__device__ __forceinline__ void seq_info(int s, int& tok0, int& L, int& pos_row0) {
    if (s < NPB) { tok0 = s * PL; L = PL; pos_row0 = 0; }
    else { tok0 = TP + (s - NPB) * SL; L = SL; pos_row0 = PL; }
}


#define XB_TMO      128
#define XB_XCNT(j)  (256  + 64 * (j))
#define XB_XSUB(j)  (1280 + 64 * (j))
#define XB_XGEN(j)  (2304 + 64 * (j))
#define XB_TOP      3328
#define XB_TOPGEN   3392
#define XCD_BAR_WORDS 3456
#define XB_SPIN_CAP (1u << 22)
#define LAS __attribute__((address_space(3)))

__device__ __forceinline__ unsigned xb_ld(unsigned* p)              { return __hip_atomic_load(p, __ATOMIC_RELAXED, __HIP_MEMORY_SCOPE_AGENT); }
__device__ __forceinline__ unsigned xb_add(unsigned* p, unsigned v) { return __hip_atomic_fetch_add(p, v, __ATOMIC_RELAXED, __HIP_MEMORY_SCOPE_AGENT); }
__device__ __forceinline__ unsigned xb_xcc_id() { return (unsigned)__builtin_amdgcn_s_getreg((3 << 11) | 20) & 0xFu; }
#define XB_SPIN(cond, bar) do { unsigned _sp = 0; while (cond) { __builtin_amdgcn_s_sleep(1); \
    if ((++_sp & 255u) == 0u) { if (xb_ld(&(bar)[XB_TMO])) break; if (_sp > XB_SPIN_CAP) { atomicAdd(&(bar)[XB_TMO], 1u); break; } } } } while (0)

struct XcdBarrier {
    unsigned* bar; unsigned x;
    volatile LAS unsigned* st;
};

__device__ __forceinline__ XcdBarrier xcd_barrier_post(unsigned* bar, volatile LAS unsigned* st) {
    XcdBarrier b; b.bar = bar; b.x = xb_xcc_id(); b.st = st;
    if (threadIdx.x == 0) (void)xb_add(&bar[XB_XCNT(b.x)], 1u);
    return b;
}
__device__ __forceinline__ void xcd_barrier_complete(unsigned* bar, unsigned x, unsigned& nloc, unsigned& nx) {
    const unsigned G = gridDim.x * gridDim.y * gridDim.z;
    unsigned sum, cnt, mine, sp = 0u;
    for (;;) {
        sum = 0u; cnt = 0u; mine = 0u;
#pragma unroll
        for (unsigned j = 0; j < 16; ++j) { const unsigned c = xb_ld(&bar[XB_XCNT(j)]); sum += c; cnt += (c > 0u) ? 1u : 0u; mine = (j == x) ? c : mine; }
        if (sum == G) break;
        __builtin_amdgcn_s_sleep(1);
        if ((++sp & 255u) == 0u) { if (xb_ld(&bar[XB_TMO])) break; if (sp > XB_SPIN_CAP) { atomicAdd(&bar[XB_TMO], 1u); break; } }
    }
    nloc = mine > 0u ? mine : 1u; nx = cnt > 0u ? cnt : 1u;
}

__device__ __forceinline__ void xcd_barrier(const XcdBarrier& b) {
    asm volatile("s_waitcnt vmcnt(0)" ::: "memory");
    __syncthreads();
    if (threadIdx.x == 0) {
        unsigned* bar = b.bar;
        __builtin_amdgcn_s_waitcnt(0);
        unsigned nloc = b.st[0], nx = b.st[1];
        if (nloc == 0u) { xcd_barrier_complete(bar, b.x, nloc, nx); b.st[0] = nloc; b.st[1] = nx; }
        const unsigned old = xb_add(&bar[XB_XSUB(b.x)], 1u);
        const unsigned gen = old / nloc;
        if (old + 1u == (gen + 1u) * nloc) {
            __builtin_amdgcn_fence(__ATOMIC_RELEASE, "agent");
            asm volatile("s_waitcnt vmcnt(0)" ::: "memory");
            const unsigned og = xb_add(&bar[XB_TOP], 1u);
            const unsigned tg = og / nx;
            if (og + 1u == (tg + 1u) * nx) xb_add(&bar[XB_TOPGEN], 1u);
            else XB_SPIN(xb_ld(&bar[XB_TOPGEN]) == tg, bar);
            __builtin_amdgcn_fence(__ATOMIC_ACQUIRE, "agent");
            xb_add(&bar[XB_XGEN(b.x)], 1u);
            asm volatile("s_waitcnt vmcnt(0)" ::: "memory");
        } else {
            XB_SPIN(xb_ld(&bar[XB_XGEN(b.x)]) == gen, bar);
            __builtin_amdgcn_fence(__ATOMIC_ACQUIRE, "agent");
            asm volatile("s_waitcnt vmcnt(0)" ::: "memory");
        }
    }
    __syncthreads();
}


namespace pg8 {
#define PG8_LAS __attribute__((address_space(3)))
typedef unsigned short bf16_t;
typedef short bf16x8 __attribute__((ext_vector_type(8)));
typedef float f32x4 __attribute__((ext_vector_type(4)));
typedef unsigned u32x4 __attribute__((ext_vector_type(4)));
typedef unsigned u32x2 __attribute__((ext_vector_type(2)));
constexpr int BM = 256, BK = 64, HALF = 128, HTB = HALF * BK * 2  , STAGE_BYTES = 8 * HTB, NXCD = 8, WGM = 8;

__host__ __device__ __forceinline__ int lds_byte(int r, int c) { const int st = (r >> 4) * 2 + (c >> 5), rr = r & 15, cc = c & 31, ob = rr * 64 + cc * 2; return st * 1024 + (ob ^ (((ob >> 9) & 1) << 5)); }
__host__ __device__ __forceinline__ void stage_rc(int b, int& R, int& C) { const int st = b / 1024, sb = b % 1024, swz = sb ^ (((sb >> 9) & 1) << 5); R = (st >> 1) * 16 + swz / 64; C = (st & 1) * 32 + (swz % 64) / 2; }
__host__ __device__ __forceinline__ int perm32(int rho) { const int n = rho >> 4, i = rho & 15; return 8 * (i >> 2) + 4 * n + (i & 3); }

struct Unit { int pm, pn; };
struct Gemm { const bf16_t* A; const bf16_t* Bt; int M, N, K; };

struct StaticOrder {
    int nM, nN, nwg, G, c;
    __host__ __device__ void init(int M, int N, int G_, int c_) { nM = M / BM; nN = N / BM; nwg = nM * nN; G = G_; c = c_; }
    __host__ __device__ bool next(int i, Unit& u) const {
        const long L = (long)i * G + c; if (L >= nwg) return false;
        int wgid = (int)L; { const int q = nwg / NXCD, r = nwg % NXCD, xcd = wgid % NXCD, off = wgid / NXCD; wgid = (xcd < r ? xcd * (q + 1) : r * (q + 1) + (xcd - r) * q) + off; }
        const int nig = WGM * nN, gid = wgid / nig, fm = gid * WGM, gsz = (nM - fm) < WGM ? (nM - fm) : WGM;
        u.pm = fm + ((wgid % nig) % gsz); u.pn = (wgid % nig) / gsz; return true;
    }
    __device__ __forceinline__ void a_ready(const Unit&) const {}
    __device__ __forceinline__ void done(const Unit&) const {}
};
__device__ __forceinline__ unsigned cvt_pk_bf16(float lo, float hi) { unsigned r; asm volatile("v_cvt_pk_bf16_f32 %0, %1, %2" : "=v"(r) : "v"(lo), "v"(hi)); return r; }
typedef float f32x2 __attribute__((ext_vector_type(2)));
__device__ __forceinline__ f32x2 gelu_pk(f32x2 v) {
    const f32x2 av = __builtin_elementwise_abs(v), d = av * 0.2316418882f + 1.0f;
    f32x2 t; t.x = __builtin_amdgcn_rcpf(d.x); t.y = __builtin_amdgcn_rcpf(d.y);
    f32x2 q = t * 0.5307027145f + (-0.7265760135f); q = q * t + 0.7107068705f; q = q * t + (-0.142248368f); q = q * t + 0.127414796f; q = q * t;
    const f32x2 s = (v * v) * (-0.72134752044f);
    f32x2 e; e.x = __builtin_amdgcn_exp2f(s.x); e.y = __builtin_amdgcn_exp2f(s.y);
    const f32x2 m = v * (q * e), r = v - m;
    f32x2 o; o.x = v.x < 0.f ? m.x : r.x; o.y = v.y < 0.f ? m.y : r.y; return o;
}

struct EpiF32 {
    static constexpr bool PERM = false, AFTER_DRAIN = false, ACC_INIT = false;
    float* C; int ldc; const float* bias;
    __device__ __forceinline__ void operator()(const f32x4 (&acc)[2][2][4][2], const Unit& u, int wr, int wc, int fr, int fq) const {
        const int row0 = u.pm * BM + wr * 64 + fr, col0 = u.pn * BM + wc * 32 + 4 * fq;
        f32x4 bv[2][2];
#pragma unroll
        for (int bj = 0; bj < 2; ++bj)
#pragma unroll
            for (int n = 0; n < 2; ++n) bv[bj][n] = bias ? *(const f32x4*)(bias + col0 + bj * HALF + n * 16) : (f32x4){0.f, 0.f, 0.f, 0.f};
#pragma unroll
        for (int ai = 0; ai < 2; ++ai)
#pragma unroll
            for (int m = 0; m < 4; ++m) { float* rowp = C + (size_t)(row0 + ai * HALF + m * 16) * ldc + col0;
#pragma unroll
                for (int bj = 0; bj < 2; ++bj)
#pragma unroll
                    for (int n = 0; n < 2; ++n) *(f32x4*)(rowp + bj * HALF + n * 16) = acc[ai][bj][m][n] + bv[bj][n]; }
    }
};
template <int ACT  > struct EpiBf16 {
    static constexpr bool PERM = true, AFTER_DRAIN = false, ACC_INIT = false;
    bf16_t* O; int ldc; const float* bias; int split_cols; size_t split_stride;
    __device__ __forceinline__ void operator()(const f32x4 (&acc)[2][2][4][2], const Unit& u, int wr, int wc, int fr, int fq) const {
        const int row0 = u.pm * BM + wr * 64 + fr; int colt = u.pn * BM; bf16_t* base = O;
        if (split_cols) { const int t = colt / split_cols; base += (size_t)t * split_stride; colt -= t * split_cols; }
        const int col0 = colt + wc * 32 + 8 * fq, bcol0 = u.pn * BM + wc * 32 + 8 * fq;
        f32x4 bv[2][2];
#pragma unroll
        for (int bj = 0; bj < 2; ++bj)
#pragma unroll
            for (int n = 0; n < 2; ++n) bv[bj][n] = bias ? *(const f32x4*)(bias + bcol0 + bj * HALF + 4 * n) : (f32x4){0.f, 0.f, 0.f, 0.f};
#pragma unroll
        for (int ai = 0; ai < 2; ++ai)
#pragma unroll
            for (int m = 0; m < 4; ++m) { bf16_t* rowp = base + (size_t)(row0 + ai * HALF + m * 16) * ldc + col0;
#pragma unroll
                for (int bj = 0; bj < 2; ++bj) { f32x4 v0 = acc[ai][bj][m][0] + bv[bj][0], v1 = acc[ai][bj][m][1] + bv[bj][1];
                    if (ACT == 1) { f32x2 a = gelu_pk((f32x2){v0[0], v0[1]}), b = gelu_pk((f32x2){v0[2], v0[3]}), c = gelu_pk((f32x2){v1[0], v1[1]}), d = gelu_pk((f32x2){v1[2], v1[3]});
                        v0 = (f32x4){a.x, a.y, b.x, b.y}; v1 = (f32x4){c.x, c.y, d.x, d.y}; }
                    if (ACT == 2) {
#pragma unroll
                        for (int j = 0; j < 4; ++j) { v0[j] = 0.5f * v0[j] * (1.0f + erff(v0[j] * 0.70710678f)); v1[j] = 0.5f * v1[j] * (1.0f + erff(v1[j] * 0.70710678f)); } }
                    u32x4 w; w.x = cvt_pk_bf16(v0[0], v0[1]); w.y = cvt_pk_bf16(v0[2], v0[3]); w.z = cvt_pk_bf16(v1[0], v1[1]); w.w = cvt_pk_bf16(v1[2], v1[3]);
                    *(u32x4*)(rowp + bj * HALF) = w; } }
    }
};

template <class Epi, class Sched, bool STAMP = false>
__device__ __forceinline__ void gemm_phase(PG8_LAS unsigned char* lds, const Gemm g, const Sched& S, const Epi& E, unsigned long long* stamps) {
    const int tid = ::opaque_tid(), wid = __builtin_amdgcn_readfirstlane(tid >> 6), lane = tid & 63, wr = wid >> 2, wc = wid & 3, fr = lane & 15, fq = lane >> 4;
    const int K = g.K, nt = K / BK;
    int ts_lo = 0, ts_hi = 0, nts = 0; const unsigned long long rt_entry = STAMP ? (unsigned long long)wall_clock64() : 0ull;
#define PG8_STAMP() do { if (STAMP && wid == 0 && nts < 64) { const unsigned long long _c = (unsigned long long)clock64(); \
        ts_lo = (lane == nts) ? (int)(unsigned)_c : ts_lo; ts_hi = (lane == nts) ? (int)(unsigned)(_c >> 32) : ts_hi; ++nts; } } while (0)
    PG8_STAMP();
    unsigned voffA[2], voffB[2];
#pragma unroll
    for (int i = 0; i < 2; ++i) { int R, C; stage_rc(tid * 16 + i * 8192, R, C); const int Rb = Epi::PERM ? ((R & ~31) + perm32(R & 31)) : R;
        voffA[i] = (unsigned)(R * K + C) * 2u; voffB[i] = (unsigned)(Rb * K + C) * 2u; }
    const size_t kstep = (size_t)(BK * 2);
    const size_t hstep = (size_t)HALF * K * 2;
    const size_t tstep = 2 * hstep;
    const unsigned ldsw = (unsigned)wid * 1024u;
    const int aoff = lds_byte(wr * 64 + fr, fq * 8), boff = lds_byte(wc * 32 + fr, fq * 8);
#define PG8_SA(b, h) (((b) * 2 + (h)) * HTB)
#define PG8_SB(b, h) ((4 + (b) * 2 + (h)) * HTB)
#define PG8_STAGE(bufoff, gbase, voff) do { _Pragma("unroll") for (int _i = 0; _i < 2; ++_i) \
        __builtin_amdgcn_global_load_lds((const unsigned*)((const char*)(gbase) + (voff)[_i]), (PG8_LAS unsigned*)(lds + (bufoff) + ldsw + _i * 8192), 16, 0, 0); } while (0)
#define PG8_LDA(dst, b, h) do { _Pragma("unroll") for (int m = 0; m < 4; ++m) _Pragma("unroll") for (int k = 0; k < 2; ++k) dst[m][k] = *(const PG8_LAS bf16x8*)(lds + PG8_SA(b, h) + aoff + m * 2048 + k * 1024); } while (0)
#define PG8_LDB(dst, b, h) do { _Pragma("unroll") for (int n = 0; n < 2; ++n) _Pragma("unroll") for (int k = 0; k < 2; ++k) dst[n][k] = *(const PG8_LAS bf16x8*)(lds + PG8_SB(b, h) + boff + n * 2048 + k * 1024); } while (0)
#define PG8_MMA(ai, bj, At, Bt) do { __builtin_amdgcn_s_setprio(1); _Pragma("unroll") for (int m = 0; m < 4; ++m) _Pragma("unroll") for (int n = 0; n < 2; ++n) _Pragma("unroll") for (int k = 0; k < 2; ++k) \
        acc[ai][bj][m][n] = __builtin_amdgcn_mfma_f32_16x16x32_bf16(Bt[n][k], At[m][k], acc[ai][bj][m][n], 0, 0, 0); __builtin_amdgcn_s_setprio(0); } while (0)
#define PG8_WAIT_V(n) asm volatile("s_waitcnt vmcnt(" #n ")" ::: "memory")
#define PG8_WAIT_L(n) asm volatile("s_waitcnt lgkmcnt(" #n ")" ::: "memory")
#define PG8_BAR __builtin_amdgcn_s_barrier()
#define PG8_SCHED __builtin_amdgcn_sched_barrier(0)
    Unit cur, nxt; int ui = 0;
    if (!S.next(0, cur)) return;
    f32x4 acc[2][2][4][2];
    if constexpr (Epi::ACC_INIT) E.init(acc, cur, wr, wc, fr, fq);
    else {
#pragma unroll
    for (int a = 0; a < 2; ++a)
#pragma unroll
        for (int b = 0; b < 2; ++b)
#pragma unroll
            for (int m = 0; m < 4; ++m)
#pragma unroll
                for (int n = 0; n < 2; ++n) acc[a][b][m][n] = (f32x4){0.f, 0.f, 0.f, 0.f};
    }
    bf16x8 At[4][2], B0[2][2], B1[2][2];
    const char* cA = (const char*)g.A + (size_t)cur.pm * tstep; const char* cB = (const char*)g.Bt + (size_t)cur.pn * tstep;
    S.a_ready(cur);
    PG8_STAGE(PG8_SB(0, 0), cB, voffB); PG8_STAGE(PG8_SA(0, 0), cA, voffA); PG8_STAGE(PG8_SB(0, 1), cB + hstep, voffB); PG8_STAGE(PG8_SA(0, 1), cA + hstep, voffA);
    if (wr == 1) PG8_BAR;
    PG8_WAIT_V(4); PG8_BAR;
    PG8_STAGE(PG8_SB(1, 0), cB + kstep, voffB); PG8_STAGE(PG8_SA(1, 0), cA + kstep, voffA); PG8_STAGE(PG8_SB(1, 1), cB + hstep + kstep, voffB);
    PG8_WAIT_V(6); PG8_BAR;
    PG8_STAMP();
    for (;;) {
        const bool has_next = S.next(ui + 1, nxt);
        const char* nA = has_next ? (const char*)g.A + (size_t)nxt.pm * tstep : cA; const char* nB = has_next ? (const char*)g.Bt + (size_t)nxt.pn * tstep : cB;
        for (int t = 0; t < nt; t += 2) {
            const bool last = (t == nt - 2);
            const char* a1 = cA + (size_t)(t + 1) * kstep;
            const char* a2 = last ? nA : cA + (size_t)(t + 2) * kstep; const char* b2 = last ? nB : cB + (size_t)(t + 2) * kstep;
            const char* a3 = a2 + kstep; const char* b3 = b2 + kstep;
            if (last && has_next) S.a_ready(nxt);
            PG8_LDB(B0, 0, 0); PG8_SCHED; PG8_LDA(At, 0, 0); PG8_STAGE(PG8_SA(1, 1), a1 + hstep, voffA);
            PG8_WAIT_L(8); PG8_BAR; PG8_WAIT_L(0); PG8_MMA(0, 0, At, B0); PG8_BAR; PG8_SCHED;
            PG8_LDB(B1, 0, 1); PG8_STAGE(PG8_SB(0, 0), b2, voffB);
            PG8_BAR; PG8_WAIT_L(0); PG8_MMA(0, 1, At, B1); PG8_BAR;
            PG8_LDA(At, 0, 1); PG8_STAGE(PG8_SA(0, 0), a2, voffA);
            PG8_BAR; PG8_WAIT_L(0); PG8_MMA(1, 0, At, B0); PG8_BAR; PG8_SCHED;
            PG8_STAGE(PG8_SB(0, 1), b2 + hstep, voffB);
            PG8_WAIT_V(6); PG8_BAR; PG8_MMA(1, 1, At, B1); PG8_BAR;
            PG8_LDB(B0, 1, 0); PG8_SCHED; PG8_LDA(At, 1, 0); PG8_STAGE(PG8_SA(0, 1), a2 + hstep, voffA);
            PG8_WAIT_L(8); PG8_BAR; PG8_WAIT_L(0); PG8_MMA(0, 0, At, B0); PG8_BAR; PG8_SCHED;
            PG8_LDB(B1, 1, 1); PG8_STAGE(PG8_SB(1, 0), b3, voffB);
            PG8_BAR; PG8_WAIT_L(0); PG8_MMA(0, 1, At, B1); PG8_BAR;
            PG8_LDA(At, 1, 1); PG8_STAGE(PG8_SA(1, 0), a3, voffA);
            PG8_BAR; PG8_WAIT_L(0); PG8_MMA(1, 0, At, B0); PG8_BAR; PG8_SCHED;
            PG8_STAGE(PG8_SB(1, 1), b3 + hstep, voffB);
            PG8_WAIT_V(6); PG8_BAR; PG8_MMA(1, 1, At, B1); PG8_BAR;
        }
        PG8_STAMP();
        if constexpr (!Epi::AFTER_DRAIN) { E(acc, cur, wr, wc, fr, fq); S.done(cur); }
        PG8_STAMP();
        if (!has_next) break;
        if constexpr (Epi::ACC_INIT) E.init(acc, nxt, wr, wc, fr, fq);
        else {
#pragma unroll
        for (int a = 0; a < 2; ++a)
#pragma unroll
            for (int b = 0; b < 2; ++b)
#pragma unroll
                for (int m = 0; m < 4; ++m)
#pragma unroll
                    for (int n = 0; n < 2; ++n) acc[a][b][m][n] = (f32x4){0.f, 0.f, 0.f, 0.f};
        }
        cur = nxt; cA = nA; cB = nB; ++ui;
    }
    PG8_WAIT_V(0);
    if (wr == 0) PG8_BAR;
    PG8_BAR;
    if constexpr (Epi::AFTER_DRAIN) { E.fused(acc, cur, wr, wc, fr, fq, lds, wid, lane); S.done(cur); }
    PG8_STAMP();
    if (STAMP && wid == 0) { stamps[lane] = lane < nts ? (((unsigned long long)(unsigned)ts_hi << 32) | (unsigned)ts_lo) : 0ull;
        if (lane == 62) stamps[62] = rt_entry; if (lane == 63) stamps[63] = (unsigned long long)wall_clock64(); }
#undef PG8_STAMP
#undef PG8_SA
#undef PG8_SB
#undef PG8_STAGE
#undef PG8_LDA
#undef PG8_LDB
#undef PG8_MMA
#undef PG8_WAIT_V
#undef PG8_WAIT_L
#undef PG8_BAR
#undef PG8_SCHED
}
}

namespace pg8 {
struct SsqRef { float* p16; float* p64; };
__device__ __forceinline__ float row_rs(const SsqRef q, int row) {
    float s = 0.f;
    if (row < 16384) { const f32x4* p = (const f32x4*)(q.p16 + (size_t)row * 16);
#pragma unroll
        for (int i = 0; i < 4; ++i) { const f32x4 v = p[i]; s += (v[0] + v[1]) + (v[2] + v[3]); }
    } else { const f32x4* p = (const f32x4*)(q.p64 + (size_t)(row - 16384) * 64);
#pragma unroll
        for (int i = 0; i < 16; ++i) { const f32x4 v = p[i]; s += (v[0] + v[1]) + (v[2] + v[3]); }
    }
    return rsqrtf(s * (1.f / 1024.f) + 1e-6f);
}
template <class Sched>
__device__ __forceinline__ void rs_table_build(PG8_LAS unsigned char* rst, const Sched& S, const SsqRef q, int tid) {
    PG8_LAS int* lst = (PG8_LAS int*)rst; PG8_LAS float* tab = (PG8_LAS float*)(rst + 32);
    int n = 0; Unit u;
    int seen[8];
#pragma unroll
    for (int k = 0; k < 8; ++k) seen[k] = -1;
#pragma unroll 1
    for (int i = 0; S.next(i, u); ++i) {
        bool dup = false;
#pragma unroll
        for (int k = 0; k < 8; ++k) dup |= (seen[k] == u.pm);
        if (dup || n >= 8) continue;
#pragma unroll
        for (int k = 0; k < 8; ++k) if (k == n) seen[k] = u.pm;
        ++n;
    }
#pragma unroll
    for (int k = 0; k < 4; ++k) {
        const int idx = tid + 512 * k, slot = idx >> 8, r = idx & 255;
        int pm = -1;
#pragma unroll
        for (int j = 0; j < 8; ++j) pm = (j == slot) ? seen[j] : pm;
        if (slot < n) tab[idx] = row_rs(q, pm * BM + r);
    }
    if (tid < 8) {
        int v = -1;
#pragma unroll
        for (int k = 0; k < 8; ++k) v = (k == tid) ? seen[k] : v;
        lst[tid] = v;
    }
    __syncthreads();
}
__device__ __forceinline__ const PG8_LAS float* rs_table_find(PG8_LAS const unsigned char* rst, int pm) {
    const PG8_LAS int* lst = (const PG8_LAS int*)rst; int k = 0;
#pragma unroll
    for (int i = 1; i < 8; ++i) k = (lst[i] == pm) ? i : k;
    return (const PG8_LAS float*)(rst + 32) + k * 256;
}
struct EpiProjS {
    static constexpr bool PERM = true, AFTER_DRAIN = false, ACC_INIT = false;
    bf16_t* O; int ldc; PG8_LAS const unsigned char* rst;
    __device__ __forceinline__ void operator()(const f32x4 (&acc)[2][2][4][2], const Unit& u, int wr, int wc, int fr, int fq) const {
        const int row0 = u.pm * BM + wr * 64 + fr, col0 = u.pn * BM + wc * 32 + 8 * fq;
        const PG8_LAS float* rsl = rs_table_find(rst, u.pm);
#pragma unroll
        for (int ai = 0; ai < 2; ++ai)
#pragma unroll
            for (int m = 0; m < 4; ++m) { const int row = row0 + ai * HALF + m * 16; const float rs = rsl[wr * 64 + fr + ai * HALF + m * 16]; bf16_t* rowp = O + (size_t)row * ldc + col0;
#pragma unroll
                for (int bj = 0; bj < 2; ++bj) { const f32x4 v0 = acc[ai][bj][m][0] * rs, v1 = acc[ai][bj][m][1] * rs;
                    u32x4 w; w.x = cvt_pk_bf16(v0[0], v0[1]); w.y = cvt_pk_bf16(v0[2], v0[3]); w.z = cvt_pk_bf16(v1[0], v1[1]); w.w = cvt_pk_bf16(v1[2], v1[3]);
                    *(u32x4*)(rowp + bj * HALF) = w; } }
    }
};
struct EpiSqrelu {
    static constexpr bool PERM = true, AFTER_DRAIN = false, ACC_INIT = false;
    bf16_t* O; int ldc; PG8_LAS const unsigned char* rst;
    __device__ __forceinline__ void operator()(const f32x4 (&acc)[2][2][4][2], const Unit& u, int wr, int wc, int fr, int fq) const {
        const int row0 = u.pm * BM + wr * 64 + fr, col0 = u.pn * BM + wc * 32 + 8 * fq;
        const PG8_LAS float* rsl = rs_table_find(rst, u.pm);
#pragma unroll
        for (int ai = 0; ai < 2; ++ai)
#pragma unroll
            for (int m = 0; m < 4; ++m) { const int row = row0 + ai * HALF + m * 16; const float rs = rsl[wr * 64 + fr + ai * HALF + m * 16]; bf16_t* rowp = O + (size_t)row * ldc + col0;
#pragma unroll
                for (int bj = 0; bj < 2; ++bj) { f32x4 v0 = acc[ai][bj][m][0], v1 = acc[ai][bj][m][1];
#pragma unroll
                    for (int j = 0; j < 4; ++j) { const float a = fmaxf(v0[j], 0.f) * rs, b = fmaxf(v1[j], 0.f) * rs; v0[j] = a * a; v1[j] = b * b; }
                    u32x4 w; w.x = cvt_pk_bf16(v0[0], v0[1]); w.y = cvt_pk_bf16(v0[2], v0[3]); w.z = cvt_pk_bf16(v1[0], v1[1]); w.w = cvt_pk_bf16(v1[2], v1[3]);
                    *(u32x4*)(rowp + bj * HALF) = w; } }
    }
};
struct EpiResN {
    static constexpr bool PERM = false, AFTER_DRAIN = false, ACC_INIT = true;
    const float* base; float* out; int ldc; bf16_t* xb; float* ssq16;
    __device__ __forceinline__ void init(f32x4 (&acc)[2][2][4][2], const Unit& u, int wr, int wc, int fr, int fq) const {
        const int row0 = u.pm * BM + wr * 64 + fr, col0 = u.pn * BM + wc * 32 + 4 * fq;
#pragma unroll
        for (int ai = 0; ai < 2; ++ai)
#pragma unroll
            for (int m = 0; m < 4; ++m)
#pragma unroll
                for (int bj = 0; bj < 2; ++bj)
#pragma unroll
                    for (int n = 0; n < 2; ++n) acc[ai][bj][m][n] = __builtin_nontemporal_load((const f32x4*)(base + (size_t)(row0 + ai * HALF + m * 16) * ldc + col0 + bj * HALF + n * 16));
    }
    __device__ __forceinline__ void operator()(const f32x4 (&acc)[2][2][4][2], const Unit& u, int wr, int wc, int fr, int fq) const {
        const int row0 = u.pm * BM + wr * 64 + fr, col0 = u.pn * BM + wc * 32 + 4 * fq;
#pragma unroll
        for (int ai = 0; ai < 2; ++ai)
#pragma unroll
            for (int m = 0; m < 4; ++m) { const int row = row0 + ai * HALF + m * 16; const size_t off = (size_t)row * ldc + col0; float ss = 0.f;
#pragma unroll
                for (int bj = 0; bj < 2; ++bj)
#pragma unroll
                    for (int n = 0; n < 2; ++n) { const f32x4 o = acc[ai][bj][m][n]; __builtin_nontemporal_store(o, (f32x4*)(out + off + bj * HALF + n * 16));
                        ss += (o[0] * o[0] + o[1] * o[1]) + (o[2] * o[2] + o[3] * o[3]);
                        u32x2 w; w.x = cvt_pk_bf16(o[0], o[1]); w.y = cvt_pk_bf16(o[2], o[3]); *(u32x2*)(xb + off + bj * HALF + n * 16) = w; }
                ss += __shfl_xor(ss, 16); ss += __shfl_xor(ss, 32);
                if (fq == 0) ssq16[(size_t)row * 16 + u.pn * 4 + wc] = ss; }
    }
};
}

__device__ __forceinline__ void k_prep_w(unsigned char* lds, const int bid, const int G, const float* __restrict__ W, bf16_t* __restrict__ Wt, int K, int N, int Npad, const float* __restrict__ scale, int period) {
    const int tid = opaque_tid();
    const int total = Npad * (K >> 3);
    for (int i = bid * NT + tid; i < total; i += 2 * G * NT) {
        float v[2][8]; int n[2], kg[2]; bool ok[2];
#pragma unroll
        for (int u = 0; u < 2; ++u) {
            const int ii = i + u * G * NT; ok[u] = ii < total; const int i2 = ok[u] ? ii : i;
            kg[u] = i2 / Npad; n[u] = i2 - kg[u] * Npad;
#pragma unroll
            for (int j = 0; j < 8; ++j) v[u][j] = (n[u] < N) ? __builtin_nontemporal_load(W + (size_t)(kg[u] * 8 + j) * N + n[u]) : 0.f;
        }
#pragma unroll
        for (int u = 0; u < 2; ++u) {
            if (scale) {
#pragma unroll
                for (int j = 0; j < 8; ++j) v[u][j] *= scale[(kg[u] * 8 + j) % period];
            }
            uint4 pk; pk.x = pack_bf2(v[u][0], v[u][1]); pk.y = pack_bf2(v[u][2], v[u][3]); pk.z = pack_bf2(v[u][4], v[u][5]); pk.w = pack_bf2(v[u][6], v[u][7]);
            if (ok[u]) *(uint4*)(Wt + (size_t)n[u] * K + kg[u] * 8) = pk;
        }
    }
}

__device__ __forceinline__ void sincos_d(double x, double& s, double& c) {
    const double q = rint(x * 0.63661977236758134308);
    double r = fma(-q, 1.57079632679489655800e+00, x);
    r = fma(-q, 6.12323399573676603587e-17, r);
    const double r2 = r * r;
    double sp = -7.6471637318198164759e-13; sp = fma(sp, r2, 1.6059043836821614599e-10); sp = fma(sp, r2, -2.5052108385441718775e-08);
    sp = fma(sp, r2, 2.7557319223985890653e-06); sp = fma(sp, r2, -1.9841269841269841270e-04); sp = fma(sp, r2, 8.3333333333333333333e-03);
    sp = fma(sp, r2, -1.6666666666666666667e-01); const double sn = fma(sp * r2, r, r);
    double cp = 4.7794773323873852974e-14; cp = fma(cp, r2, -1.1470745597729724714e-11); cp = fma(cp, r2, 2.0876756987868098979e-09);
    cp = fma(cp, r2, -2.7557319223985890653e-07); cp = fma(cp, r2, 2.4801587301587301587e-05); cp = fma(cp, r2, -1.3888888888888888889e-03);
    cp = fma(cp, r2, 4.1666666666666666667e-02); cp = fma(cp, r2, -0.5); const double cs = fma(cp, r2, 1.0);
    const int qi = ((int)q) & 3;
    s = (qi == 0) ? sn : (qi == 1) ? cs : (qi == 2) ? -sn : -cs;
    c = (qi == 0) ? cs : (qi == 1) ? -sn : (qi == 2) ? -cs : sn;
}
__device__ __forceinline__ void k_rope(unsigned char* lds, const int bid, const int G, float* __restrict__ rope) {
    const int tid = opaque_tid();
    for (int idx = bid * NT + tid; idx < (PL + SL) * 128; idx += G * NT) {
    const int p = idx >> 7, i = idx & 127;
    const double pos = (p < PL) ? (double)p : (double)(PAST + p - PL);
    double inv = 1.0, b = 0.93057204092969897; int e = i;
    while (e) { if (e & 1) inv *= b; b *= b; e >>= 1; }
    double s, c; sincos_d(pos * inv, s, c);
    rope[(size_t)idx * 2] = (float)c; rope[(size_t)idx * 2 + 1] = (float)s;
    }
}

__device__ __forceinline__ void unpack_bf8(const uint4 r, float (&f)[8]) {
    f[0] = __uint_as_float(r.x << 16); f[1] = __uint_as_float(r.x & 0xffff0000u); f[2] = __uint_as_float(r.y << 16); f[3] = __uint_as_float(r.y & 0xffff0000u);
    f[4] = __uint_as_float(r.z << 16); f[5] = __uint_as_float(r.z & 0xffff0000u); f[6] = __uint_as_float(r.w << 16); f[7] = __uint_as_float(r.w & 0xffff0000u);
}
__device__ __forceinline__ void unpack_bf4(const uint2 r, float (&f)[4]) {
    f[0] = __uint_as_float(r.x << 16); f[1] = __uint_as_float(r.x & 0xffff0000u); f[2] = __uint_as_float(r.y << 16); f[3] = __uint_as_float(r.y & 0xffff0000u);
}

__device__ __forceinline__ void k_x_prep(unsigned char* lds, const int bid, const int G, const float* __restrict__ xp, const float* __restrict__ xs, float* __restrict__ xres, bf16_t* __restrict__ xb, const pg8::SsqRef ssq) {
    const int tid = opaque_tid(), lane = tid & 63, w = tid >> 6;
    for (int row = bid * 8 + w; row < T; row += G * 8) {
        const float4* xr = (const float4*)((row < TP) ? xp + (size_t)row * D : xs + (size_t)(row - TP) * D);
        float4 v[4]; float ss = 0.f;
#pragma unroll
        for (int i = 0; i < 4; ++i) { v[i] = ld_nt4((const float*)(xr + lane + 64 * i)); ss += v[i].x * v[i].x + v[i].y * v[i].y + v[i].z * v[i].z + v[i].w * v[i].w; }
        ss = wave_sum(ss);
        if (row < TP) { if (lane < 4) *(float4*)(ssq.p16 + (size_t)row * 16 + lane * 4) = make_float4(lane == 0 ? ss : 0.f, 0.f, 0.f, 0.f); }
        else if (lane < 16) *(float4*)(ssq.p64 + (size_t)(row - TP) * 64 + lane * 4) = make_float4(lane == 0 ? ss : 0.f, 0.f, 0.f, 0.f);
        float4* o = (float4*)(xres + (size_t)row * D); uint2* ob = (uint2*)(xb + (size_t)row * D);
#pragma unroll
        for (int i = 0; i < 4; ++i) { o[lane + 64 * i] = v[i]; uint2 pk; pk.x = pack_bf2(v[i].x, v[i].y); pk.y = pack_bf2(v[i].z, v[i].w); ob[lane + 64 * i] = pk; }
    }
}

__device__ __forceinline__ void k_final_norm(unsigned char* lds, const int bid, const int G, const float* __restrict__ xres, const pg8::SsqRef ssq, const float* __restrict__ wgt, float* __restrict__ out) {
    const int tid = opaque_tid(), lane = tid & 63, w = tid >> 6;
    for (int row = bid * 8 + w; row < T; row += G * 8) {
        const float4* xr = (const float4*)(xres + (size_t)row * D);
        const float rs = pg8::row_rs(ssq, row);
        float4* o = (float4*)(out + (size_t)row * D);
#pragma unroll
        for (int i = 0; i < 4; ++i) { const float4 v = ld_nt4((const float*)(xr + lane + 64 * i)); const float4 g = ((const float4*)wgt)[lane + 64 * i]; float4 r; r.x = v.x * rs * g.x; r.y = v.y * rs * g.y; r.z = v.z * rs * g.z; r.w = v.w * rs * g.w; st_nt4((float*)(o + lane + 64 * i), r.x, r.y, r.z, r.w); }
    }
}

template <int KIND>
__device__ __forceinline__ void gate_row_finish(float4 (&y)[8], const uint2 (&gp)[8], uint2* __restrict__ o, int lane) {
    float ssq[8];
#pragma unroll
    for (int i = 0; i < 8; ++i) {
        if (KIND == 1) { float g[4]; unpack_bf4(gp[i], g); y[i].x *= silu_f(g[0]); y[i].y *= silu_f(g[1]); y[i].z *= silu_f(g[2]); y[i].w *= silu_f(g[3]); }
        ssq[i] = (y[i].x * y[i].x + y[i].y * y[i].y) + (y[i].z * y[i].z + y[i].w * y[i].w);
    }
    float rs[8];
    if (KIND == 0) {
#pragma unroll
        for (int h = 0; h < 4; ++h) { const float r = rsqrtf(wave_sum(ssq[2 * h] + ssq[2 * h + 1]) * (1.f / 512.f) + EPS); rs[2 * h] = r; rs[2 * h + 1] = r; }
    } else if (KIND == 1) {
#pragma unroll
        for (int i = 0; i < 8; ++i) rs[i] = rsqrtf(wave_sum(ssq[i]) * (1.f / 256.f) + EPS);
    } else {
#pragma unroll
        for (int i = 0; i < 8; ++i) rs[i] = rsqrtf(half_sum(ssq[i]) * (1.f / 128.f) + EPS);
    }
#pragma unroll
    for (int i = 0; i < 8; ++i) {
        float r[4] = { y[i].x * rs[i], y[i].y * rs[i], y[i].z * rs[i], y[i].w * rs[i] };
        if (KIND != 1) { float g[4]; unpack_bf4(gp[i], g);
#pragma unroll
            for (int j = 0; j < 4; ++j) r[j] *= silu_f(g[j]); }
        uint2 pk; pk.x = pack_bf2(r[0], r[1]); pk.y = pack_bf2(r[2], r[3]); o[lane + 64 * i] = pk;
    }
}
template <int KIND>
__device__ __forceinline__ void k_gate(unsigned char* lds, const int bid, const int G, const float* __restrict__ ymix, const bf16_t* __restrict__ proj, bf16_t* __restrict__ ab) {
    const int tid = opaque_tid(), lane = tid & 63, w = tid >> 6;
    const int gcol0 = (KIND == 1) ? 0 : 4096;
    for (int row = bid * 8 + w; row < T; row += 2 * G * 8) {
        const int row2 = row + G * 8; const bool has2 = row2 < T; const int r2 = has2 ? row2 : row;
        const float4* yr = (const float4*)(ymix + (size_t)row * 2048); const float4* yr2 = (const float4*)(ymix + (size_t)r2 * 2048);
        const uint2* gr = (const uint2*)(proj + (size_t)row * NIN + gcol0); const uint2* gr2 = (const uint2*)(proj + (size_t)r2 * NIN + gcol0);
        float4 y[8], y2[8]; uint2 gp[8], gp2[8];
#pragma unroll
        for (int i = 0; i < 8; ++i) { y[i] = ld_nt4((const float*)(yr + lane + 64 * i)); gp[i] = ld_nt_u2(gr + lane + 64 * i); }
#pragma unroll
        for (int i = 0; i < 8; ++i) { y2[i] = ld_nt4((const float*)(yr2 + lane + 64 * i)); gp2[i] = ld_nt_u2(gr2 + lane + 64 * i); }
        gate_row_finish<KIND>(y, gp, (uint2*)(ab + (size_t)row * 2048), lane);
        if (has2) gate_row_finish<KIND>(y2, gp2, (uint2*)(ab + (size_t)row2 * 2048), lane);
    }
}

template <int MODE>
__device__ __forceinline__ void k_conv_pre(unsigned char* lds, const int bid, const int G, const bf16_t* __restrict__ proj, const float* __restrict__ cstate, const float* __restrict__ cw, const float* __restrict__ cb,
                                           const float* __restrict__ dt_bias, const float* __restrict__ a_log,
                                           bf16_t* __restrict__ act, float* __restrict__ sm1, float* __restrict__ sm2,
                                           float* __restrict__ pconv, float* __restrict__ sconv) {
    const int tid = opaque_tid();
    const int c0 = tid * 8, pc0 = ((MODE == 1) ? 2048 : 0) + c0;
    float wt[4][8], bias[8];
#pragma unroll
    for (int tap = 0; tap < 4; ++tap) { const float4 a = *(const float4*)(cw + tap * 4096 + c0), b = *(const float4*)(cw + tap * 4096 + c0 + 4);
        wt[tap][0] = a.x; wt[tap][1] = a.y; wt[tap][2] = a.z; wt[tap][3] = a.w; wt[tap][4] = b.x; wt[tap][5] = b.y; wt[tap][6] = b.z; wt[tap][7] = b.w; }
#pragma unroll
    for (int j = 0; j < 8; ++j) bias[j] = (MODE == 1) ? cb[c0 + j] : 0.f;
    const int nsm = (MODE == 1) ? 32 : 16;
    float hb = 0.f, hA = 0.f;
    if (tid < nsm) { hb = dt_bias[tid]; hA = -__expf(a_log[tid]); }
    for (int unit = bid; unit < 256 + NSB; unit += G) {
        const bool samp = unit >= 256;
        int row0, nrows, b, tfirst;
        if (!samp) { b = unit >> 5; tfirst = (unit & 31) * 64; row0 = b * PL + tfirst; nrows = 64; }
        else { b = unit - 256; tfirst = 0; row0 = TP + b * SL; nrows = SL; }
        const int L = samp ? SL : PL;
        float h[3][8];
#pragma unroll
        for (int i = 0; i < 3; ++i) {
            if (samp) { const float4 a = *(const float4*)(cstate + ((size_t)b * 3 + i) * 4096 + c0), bb = *(const float4*)(cstate + ((size_t)b * 3 + i) * 4096 + c0 + 4);
                h[i][0] = a.x; h[i][1] = a.y; h[i][2] = a.z; h[i][3] = a.w; h[i][4] = bb.x; h[i][5] = bb.y; h[i][6] = bb.z; h[i][7] = bb.w; }
            else if (tfirst > 0) unpack_bf8(*(const uint4*)(proj + (size_t)(row0 - 3 + i) * NIN + pc0), h[i]);
            else {
#pragma unroll
                for (int j = 0; j < 8; ++j) h[i][j] = 0.f; }
        }
        float csum = 0.f;
        constexpr int CB = 8;
        uint4 nraw[CB]; bf16_t ns1[CB], ns2[CB];
#pragma unroll
        for (int k = 0; k < CB; ++k) {
            ns1[k] = 0; ns2[k] = 0; nraw[k] = make_uint4(0u, 0u, 0u, 0u);
            if (k < nrows) {
                nraw[k] = ld_nt_u4(proj + (size_t)(row0 + k) * NIN + pc0);
                if (tid < nsm) { ns1[k] = proj[(size_t)(row0 + k) * NIN + 6144 + tid]; if (MODE == 2) ns2[k] = proj[(size_t)(row0 + k) * NIN + 6160 + tid]; }
            }
        }
#pragma unroll 1
        for (int r0 = 0; r0 < nrows; r0 += CB) {
            uint4 craw[CB]; bf16_t cs1[CB], cs2[CB];
#pragma unroll
            for (int k = 0; k < CB; ++k) { craw[k] = nraw[k]; cs1[k] = ns1[k]; cs2[k] = ns2[k]; }
            if (r0 + CB < nrows) {
#pragma unroll
                for (int k = 0; k < CB; ++k) {
                    nraw[k] = ld_nt_u4(proj + (size_t)(row0 + r0 + CB + k) * NIN + pc0);
                    if (tid < nsm) { ns1[k] = proj[(size_t)(row0 + r0 + CB + k) * NIN + 6144 + tid]; if (MODE == 2) ns2[k] = proj[(size_t)(row0 + r0 + CB + k) * NIN + 6160 + tid]; }
                }
            }
#pragma unroll
            for (int k = 0; k < CB; ++k) {
                if (r0 + k >= nrows) break;
                const int row = row0 + r0 + k, t = tfirst + r0 + k;
                float raw[8]; unpack_bf8(craw[k], raw);
                float a[8];
#pragma unroll
                for (int j = 0; j < 8; ++j) {
                    const float acc = bias[j] + h[0][j] * wt[0][j] + h[1][j] * wt[1][j] + h[2][j] * wt[2][j] + raw[j] * wt[3][j];
                    a[j] = silu_f(acc);
                    h[0][j] = h[1][j]; h[1][j] = h[2][j]; h[2][j] = raw[j];
                }
                if (MODE == 2) {
                    if (tid < 256) {
                        float ss = 0.f;
#pragma unroll
                        for (int j = 0; j < 8; ++j) ss += a[j] * a[j];
                        ss = row16_sum(ss);
                        const float sc = rsqrtf(ss + EPS) * ((tid < 128) ? 0.08838834764831845f : 1.f);
#pragma unroll
                        for (int j = 0; j < 8; ++j) a[j] *= sc;
                    }
                }
                uint4 pk; pk.x = pack_bf2(a[0], a[1]); pk.y = pack_bf2(a[2], a[3]); pk.z = pack_bf2(a[4], a[5]); pk.w = pack_bf2(a[6], a[7]);
                *(uint4*)(act + (size_t)row * 4096 + c0) = pk;
                if (t >= L - 3) {
                    float* dst = (samp ? sconv : pconv) + ((size_t)b * 3 + (t - (L - 3))) * 4096 + c0;
                    *(float4*)dst = make_float4(raw[0], raw[1], raw[2], raw[3]); *(float4*)(dst + 4) = make_float4(raw[4], raw[5], raw[6], raw[7]);
                }
                if (tid < nsm) {
                    if (MODE == 1) {
                        const float dt = softplus_f(bf2f(cs1[k]) + hb);
                        csum += dt * hA;
                        sm1[(size_t)row * 32 + tid] = dt; sm2[(size_t)row * 32 + tid] = csum;
                    } else {
                        const float beta = sigmoid_f(bf2f(cs1[k]));
                        const float g = hA * softplus_f(bf2f(cs2[k]) + hb);
                        csum += g;
                        sm1[(size_t)row * 16 + tid] = beta; sm2[(size_t)row * 32 + tid] = g; sm2[(size_t)row * 32 + 16 + tid] = csum;
                    }
                }
            }
        }
    }
}

__device__ __forceinline__ void k_ret_scan(unsigned char* lds, const int bid, const int G, const bf16_t* __restrict__ proj, const bf16_t* __restrict__ rope_qk, const float* __restrict__ s_in  ,
                                                 float* __restrict__ ymix, float* __restrict__ p_out, float* __restrict__ s_out) {
    float (*qs)[256] = (float (*)[256])lds; float (*ks)[256] = (float (*)[256])(lds + 4096); float (*vs)[64] = (float (*)[64])(lds + 8192); float (*red)[4][64] = (float (*)[4][64])(lds + 9216);
    const int tid = opaque_tid(), lane = tid & 63, wv = tid >> 6, c4 = tid & 15, dg = tid >> 4;
    for (int unit = NPB * 32 + bid; unit < NSEQ * 32; unit += G) {
        const int s = unit >> 5, h = (unit >> 3) & 3, sl = unit & 7;
        int tok0, L, prow0; seq_info(s, tok0, L, prow0);
        const float gamma = 1.f - exp2f(-5.f - (float)h);
        const size_t st_off = (((size_t)(s < NPB ? s : s - NPB) * 4 + h) * 256) * 512 + sl * 64 + c4 * 4;
        float S[8][4];
#pragma unroll
        for (int r = 0; r < 8; ++r) {
            float4 v = make_float4(0.f, 0.f, 0.f, 0.f);
            if (s >= NPB) v = ld_nt4(s_in + st_off + (size_t)(dg * 8 + r) * 512);
            S[r][0] = v.x; S[r][1] = v.y; S[r][2] = v.z; S[r][3] = v.w;
        }
        for (int t0 = 0; t0 < L; t0 += 4) {
            __syncthreads();
            {
                const int tt = tid >> 7, i = tid & 127;
                const size_t rb = (size_t)(tok0 + t0 + tt) * 4096;
                qs[tt][i] = bf2f(rope_qk[rb + h * 256 + i]); qs[tt][i + 128] = bf2f(rope_qk[rb + h * 256 + 128 + i]);
                ks[tt][i] = bf2f(rope_qk[rb + 1024 + h * 256 + i]); ks[tt][i + 128] = bf2f(rope_qk[rb + 1024 + h * 256 + 128 + i]);
                if (tid < 256) { const int t2 = tid >> 6, c = tid & 63; vs[t2][c] = bf2f(proj[(size_t)(tok0 + t0 + t2) * NIN + 2048 + h * 512 + sl * 64 + c]); }
            }
            __syncthreads();
#pragma unroll 1
            for (int tt = 0; tt < 4; ++tt) {
                const float4 vv = *(const float4*)(&vs[tt][c4 * 4]);
                const float vvv[4] = { vv.x, vv.y, vv.z, vv.w };
                float yp[4] = { 0.f, 0.f, 0.f, 0.f };
#pragma unroll
                for (int r = 0; r < 8; ++r) {
                    const float kk = ks[tt][dg * 8 + r], qq = qs[tt][dg * 8 + r];
#pragma unroll
                    for (int j = 0; j < 4; ++j) { S[r][j] = gamma * S[r][j] + kk * vvv[j]; yp[j] += qq * S[r][j]; }
                }
#pragma unroll
                for (int j = 0; j < 4; ++j) { float v = yp[j]; v += __shfl_xor(v, 16); v += __shfl_xor(v, 32); yp[j] = v; }
                if (lane < 16) *(float4*)(&red[wv][tt][c4 * 4]) = make_float4(yp[0], yp[1], yp[2], yp[3]);
            }
            __syncthreads();
            if (tid < 256) {
                const int tt = tid >> 6, c = tid & 63; float a = 0.f;
#pragma unroll
                for (int w = 0; w < 8; ++w) a += red[w][tt][c];
                ymix[(size_t)(tok0 + t0 + tt) * 2048 + h * 512 + sl * 64 + c] = a;
            }
        }
        float* so = (s < NPB) ? p_out : s_out;
#pragma unroll
        for (int r = 0; r < 8; ++r) st_nt4(so + st_off + (size_t)(dg * 8 + r) * 512, S[r][0], S[r][1], S[r][2], S[r][3]);
    }
}

__device__ __forceinline__ void k_ssd_scan(unsigned char* lds, const int bid, const int G, const bf16_t* __restrict__ act, const float* __restrict__ dtv, const float* __restrict__ a_log, const float* __restrict__ dskip,
                                                 const float* __restrict__ s_in  , float* __restrict__ ymix, float* __restrict__ p_out, float* __restrict__ s_out) {
    float (*xs)[64] = (float (*)[64])lds; float (*Bs)[128] = (float (*)[128])(lds + 1024); float (*Cs)[128] = (float (*)[128])(lds + 3072); float* dts = (float*)(lds + 5120);
    const int tid = opaque_tid(), n4 = tid & 31, pg = tid >> 5;
    const int tt_l = tid >> 7, i_l = tid & 127;
    float4 Sn[4]; bf16_t nB = 0, nC = 0, nX = 0; float nD = 0.f;
    int unit = NPB * 32 + bid;
    if (unit < NSEQ * 32) {
        const int sb = (unit >> 5) - NPB, hh = unit & 31, g = hh >> 2;
#pragma unroll
        for (int r = 0; r < 4; ++r) Sn[r] = ld_nt4(s_in + (((size_t)sb * 32 + hh) * 64 + pg * 4 + r) * 128 + n4 * 4);
        const size_t rb = (size_t)(TP + sb * SL + tt_l) * 4096;
        nB = act[rb + 2048 + g * 128 + i_l]; nC = act[rb + 3072 + g * 128 + i_l]; if (i_l < 64) nX = act[rb + hh * 64 + i_l];
        if (i_l == 64) nD = dtv[(size_t)(TP + sb * SL + tt_l) * 32 + hh];
    }
    for (; unit < NSEQ * 32; unit += G) {
        const int sb = (unit >> 5) - NPB, hh = unit & 31;
        const int tok0 = TP + sb * SL;
        const float A = -__expf(a_log[hh]), Dk = dskip[hh];
        const size_t st_off = (((size_t)sb * 32 + hh) * 64) * 128 + n4 * 4;
        float S[4][4];
#pragma unroll
        for (int r = 0; r < 4; ++r) { S[r][0] = Sn[r].x; S[r][1] = Sn[r].y; S[r][2] = Sn[r].z; S[r][3] = Sn[r].w; }
        __syncthreads();
        Bs[tt_l][i_l] = bf2f(nB); Cs[tt_l][i_l] = bf2f(nC); if (i_l < 64) xs[tt_l][i_l] = bf2f(nX); if (i_l == 64) dts[tt_l] = nD;
        __syncthreads();
        {
            const int un = unit + G;
            if (un < NSEQ * 32) {
                const int sb2 = (un >> 5) - NPB, hh2 = un & 31, g2 = hh2 >> 2;
#pragma unroll
                for (int r = 0; r < 4; ++r) Sn[r] = ld_nt4(s_in + (((size_t)sb2 * 32 + hh2) * 64 + pg * 4 + r) * 128 + n4 * 4);
                const size_t rb = (size_t)(TP + sb2 * SL + tt_l) * 4096;
                nB = act[rb + 2048 + g2 * 128 + i_l]; nC = act[rb + 3072 + g2 * 128 + i_l]; if (i_l < 64) nX = act[rb + hh2 * 64 + i_l];
                if (i_l == 64) nD = dtv[(size_t)(TP + sb2 * SL + tt_l) * 32 + hh2];
            }
        }
#pragma unroll
        for (int tt = 0; tt < 4; ++tt) {
            const float dt = dts[tt], a = __expf(dt * A);
            const float4 bv = *(const float4*)(&Bs[tt][n4 * 4]), cv = *(const float4*)(&Cs[tt][n4 * 4]);
            const float bb[4] = { bv.x, bv.y, bv.z, bv.w }, cc[4] = { cv.x, cv.y, cv.z, cv.w };
            float yp[4];
#pragma unroll
            for (int r = 0; r < 4; ++r) {
                const float xv = xs[tt][pg * 4 + r], xd = xv * dt;
                float acc = 0.f;
#pragma unroll
                for (int j = 0; j < 4; ++j) { S[r][j] = a * S[r][j] + xd * bb[j]; acc += S[r][j] * cc[j]; }
                acc = half_sum(acc);
                yp[r] = acc + Dk * xv;
            }
            if (n4 == 0) *(float4*)(ymix + (size_t)(tok0 + tt) * 2048 + hh * 64 + pg * 4) = make_float4(yp[0], yp[1], yp[2], yp[3]);
        }
#pragma unroll
        for (int r = 0; r < 4; ++r) st_nt4(s_out + st_off + (size_t)(pg * 4 + r) * 128, S[r][0], S[r][1], S[r][2], S[r][3]);
    }
}

__device__ __forceinline__ void k_gdn_scan(unsigned char* lds, const int bid, const int G, const bf16_t* __restrict__ act, const float* __restrict__ betav, const float* __restrict__ gv,
                                                 const float* __restrict__ s_in  , float* __restrict__ ymix, float* __restrict__ p_out, float* __restrict__ s_out) {
    float (*qs)[128] = (float (*)[128])lds; float (*ks)[128] = (float (*)[128])(lds + 2048); float (*vs)[128] = (float (*)[128])(lds + 4096); float* gs = (float*)(lds + 6144); float* bs = (float*)(lds + 6160);
    float (*red)[8][128] = (float (*)[8][128])(lds + 6400); float (*ored)[4][128] = (float (*)[4][128])(lds + 6400 + 8192);
    const int tid = opaque_tid(), lane = tid & 63, wv = tid >> 6, v4 = tid & 31, kg = tid >> 5;
    for (int unit = NPB * 16 + bid; unit < NSEQ * 16; unit += G) {
        const int s = unit >> 4, hv = unit & 15, hk = hv >> 1;
        int tok0, L, prow0; seq_info(s, tok0, L, prow0);
        const size_t st_off = (((size_t)(s < NPB ? s : s - NPB) * 16 + hv) * 128) * 128 + v4 * 4;
        float S[8][4];
#pragma unroll
        for (int r = 0; r < 8; ++r) {
            float4 v = make_float4(0.f, 0.f, 0.f, 0.f);
            if (s >= NPB) v = ld_nt4(s_in + st_off + (size_t)(kg * 8 + r) * 128);
            S[r][0] = v.x; S[r][1] = v.y; S[r][2] = v.z; S[r][3] = v.w;
        }
        for (int t0 = 0; t0 < L; t0 += 4) {
            __syncthreads();
            {
                const int tt = tid >> 7, i = tid & 127;
                const size_t rb = (size_t)(tok0 + t0 + tt) * 4096;
                qs[tt][i] = bf2f(act[rb + hk * 128 + i]);
                ks[tt][i] = bf2f(act[rb + 1024 + hk * 128 + i]);
                vs[tt][i] = bf2f(act[rb + 2048 + hv * 128 + i]);
                if (i == 0) { gs[tt] = gv[(size_t)(tok0 + t0 + tt) * 32 + hv]; bs[tt] = betav[(size_t)(tok0 + t0 + tt) * 16 + hv]; }
            }
            __syncthreads();
#pragma unroll 1
            for (int tt = 0; tt < 4; ++tt) {
                const float eg = __expf(gs[tt]), beta = bs[tt];
                float kr[8], part[4] = { 0.f, 0.f, 0.f, 0.f };
#pragma unroll
                for (int r = 0; r < 8; ++r) {
                    kr[r] = ks[tt][kg * 8 + r];
#pragma unroll
                    for (int j = 0; j < 4; ++j) { S[r][j] *= eg; part[j] += S[r][j] * kr[r]; }
                }
#pragma unroll
                for (int j = 0; j < 4; ++j) part[j] += __shfl_xor(part[j], 32);
                if (lane < 32) *(float4*)(&red[tt & 1][wv][v4 * 4]) = make_float4(part[0], part[1], part[2], part[3]);
                __syncthreads();
                float kS[4] = { 0.f, 0.f, 0.f, 0.f };
#pragma unroll
                for (int w = 0; w < 8; ++w) { const float4 pv = *(const float4*)(&red[tt & 1][w][v4 * 4]); kS[0] += pv.x; kS[1] += pv.y; kS[2] += pv.z; kS[3] += pv.w; }
                const float4 vv = *(const float4*)(&vs[tt][v4 * 4]);
                const float dl[4] = { beta * (vv.x - kS[0]), beta * (vv.y - kS[1]), beta * (vv.z - kS[2]), beta * (vv.w - kS[3]) };
                float op[4] = { 0.f, 0.f, 0.f, 0.f };
#pragma unroll
                for (int r = 0; r < 8; ++r) {
                    const float qq = qs[tt][kg * 8 + r];
#pragma unroll
                    for (int j = 0; j < 4; ++j) { S[r][j] += kr[r] * dl[j]; op[j] += S[r][j] * qq; }
                }
#pragma unroll
                for (int j = 0; j < 4; ++j) op[j] += __shfl_xor(op[j], 32);
                if (lane < 32) *(float4*)(&ored[wv][tt][v4 * 4]) = make_float4(op[0], op[1], op[2], op[3]);
            }
            __syncthreads();
            {
                const int tt = tid >> 7, c = tid & 127; float a = 0.f;
#pragma unroll
                for (int w = 0; w < 8; ++w) a += ored[w][tt][c];
                ymix[(size_t)(tok0 + t0 + tt) * 2048 + hv * 128 + c] = a;
            }
        }
        float* so = (s < NPB) ? p_out : s_out;
#pragma unroll
        for (int r = 0; r < 8; ++r) st_nt4(so + st_off + (size_t)(kg * 8 + r) * 128, S[r][0], S[r][1], S[r][2], S[r][3]);
    }
}

typedef pg8::bf16x8 bf16x8;
typedef pg8::f32x4 f32x4;
typedef pg8::u32x4 u32x4;
typedef pg8::u32x2 u32x2;
#define MFMA16(a, b, c) __builtin_amdgcn_mfma_f32_16x16x32_bf16((a), (b), (c), 0, 0, 0)
__device__ __forceinline__ bf16x8 ld_frag(LAS unsigned char* base, int row, int ld, int k) { return *(const LAS bf16x8*)(base + (row * ld + k) * 2); }
__device__ __forceinline__ u32x2 pack_bf4(float a, float b, float c, float d) { u32x2 r; r.x = pg8::cvt_pk_bf16(a, b); r.y = pg8::cvt_pk_bf16(c, d); return r; }
__device__ __forceinline__ float lds_bf(LAS unsigned char* base, int idx) { return __uint_as_float(((uint32_t)*(const LAS bf16_t*)(base + idx * 2)) << 16); }

template <int KS>
__device__ __forceinline__ void mma_2tiles(f32x4 (&acc)[2], LAS unsigned char* A, int arow, int lda, LAS unsigned char* B, int brow0, int brow1, int ldb, int quad) {
    constexpr int KB = (KS < 4) ? KS : 4;
#pragma unroll
    for (int kh = 0; kh < KS / KB; ++kh) {
        bf16x8 fa[KB], fb0[KB], fb1[KB];
#pragma unroll
        for (int ks = 0; ks < KB; ++ks) { const int k = (kh * KB + ks) * 32 + quad * 8; fa[ks] = ld_frag(A, arow, lda, k); fb0[ks] = ld_frag(B, brow0, ldb, k); fb1[ks] = ld_frag(B, brow1, ldb, k); }
        __builtin_amdgcn_sched_barrier(0);
#pragma unroll
        for (int ks = 0; ks < KB; ++ks) { acc[0] = MFMA16(fa[ks], fb0[ks], acc[0]); acc[1] = MFMA16(fa[ks], fb1[ks], acc[1]); }
        __builtin_amdgcn_sched_barrier(0);
    }
}
template <int MT>
__device__ __forceinline__ void mma_state(f32x4 (&acc)[MT][4], LAS unsigned char* A, int arow0, int lda, LAS unsigned char* B, int ldb, int l15, int quad) {
    bf16x8 fa[2][MT], fb[2][4];
#pragma unroll
    for (int ks = 0; ks < 2; ++ks) {
#pragma unroll
        for (int m = 0; m < MT; ++m) fa[ks][m] = ld_frag(A, arow0 + 16 * m + l15, lda, ks * 32 + quad * 8);
#pragma unroll
        for (int n = 0; n < 4; ++n) fb[ks][n] = ld_frag(B, n * 16 + l15, ldb, ks * 32 + quad * 8);
    }
    __builtin_amdgcn_sched_barrier(0);
#pragma unroll
    for (int ks = 0; ks < 2; ++ks)
#pragma unroll
        for (int m = 0; m < MT; ++m)
#pragma unroll
            for (int n = 0; n < 4; ++n) acc[m][n] = MFMA16(fa[ks][m], fb[ks][n], acc[m][n]);
    __builtin_amdgcn_sched_barrier(0);
}

constexpr int SC_CS = 0, SC_BS = SC_CS + 64 * 136 * 2, SC_BT = SC_BS + 64 * 136 * 2, SC_XR = SC_BT + 128 * 72 * 2, SC_XT = SC_XR + 64 * 72 * 2, SC_XD = SC_XT + 64 * 72 * 2,
              SC_ST = SC_XD + 64 * 72 * 2, SC_PS = SC_ST + 64 * 136 * 2, SC_CT = SC_PS + 64 * 72 * 2, SC_DT = SC_CT + 256, SC_END = SC_DT + 256;
static_assert(SC_END <= 131072, "ssd chunk LDS");
__device__ __forceinline__ void k_ssd_chunk(unsigned char* lds_, const int bid, const int G, const bf16_t* __restrict__ act, const float* __restrict__ dtv, const float* __restrict__ ctv,
                                            const float* __restrict__ dskip, float* __restrict__ ymix, float* __restrict__ p_out) {
    LAS unsigned char* lds = (LAS unsigned char*)lds_;
    const int tid = opaque_tid(), lane = tid & 63, w = __builtin_amdgcn_readfirstlane(tid >> 6), l15 = lane & 15, quad = lane >> 4;
    LAS float* ctl = (LAS float*)(lds + SC_CT); LAS float* dtl = (LAS float*)(lds + SC_DT);
    for (int unit = bid; unit < NPB * 32; unit += G) {
        const int un = xcd_unit(unit, G), b = un >> 5, hh = un & 31, g = hh >> 2;
        const float Dk = dskip[hh];
        f32x4 Sacc[4];
#pragma unroll
        for (int i = 0; i < 4; ++i) Sacc[i] = (f32x4){0.f, 0.f, 0.f, 0.f};
        for (int i = tid; i < 64 * 136 / 8; i += NT) *(LAS u32x4*)(lds + SC_ST + i * 16) = (u32x4){0u, 0u, 0u, 0u};
        u32x4 rc[2], rb[2], rx; float rct = 0.f, rdt = 0.f;
        const int r_cb = tid >> 4, c_cb = (tid & 15) * 8;
        const int r_x = tid >> 3, c_x = (tid & 7) * 8;
        {
            const size_t rowbase = (size_t)b * PL;
#pragma unroll
            for (int k = 0; k < 2; ++k) { const bf16_t* rp = act + (rowbase + r_cb + 32 * k) * 4096; rc[k] = *(const u32x4*)(rp + 3072 + g * 128 + c_cb); rb[k] = *(const u32x4*)(rp + 2048 + g * 128 + c_cb); }
            rx = __builtin_nontemporal_load((const u32x4*)(act + (rowbase + r_x) * 4096 + hh * 64 + c_x));
            if (tid < 64) { rct = ctv[(rowbase + tid) * 32 + hh]; rdt = dtv[(rowbase + tid) * 32 + hh]; }
        }
        for (int c = 0; c < 32; ++c) {
            const size_t rowbase = (size_t)b * PL + c * 64;
#pragma unroll
            for (int k = 0; k < 2; ++k) { *(LAS u32x4*)(lds + SC_CS + ((r_cb + 32 * k) * 136 + c_cb) * 2) = rc[k]; *(LAS u32x4*)(lds + SC_BS + ((r_cb + 32 * k) * 136 + c_cb) * 2) = rb[k]; }
            *(LAS u32x4*)(lds + SC_XR + (r_x * 72 + c_x) * 2) = rx;
            if (tid < 64) { ctl[tid] = rct; dtl[tid] = rdt; }
            __syncthreads();
            if (c + 1 < 32) {
                const size_t nb = rowbase + 64;
#pragma unroll
                for (int k = 0; k < 2; ++k) { const bf16_t* rp = act + (nb + r_cb + 32 * k) * 4096; rc[k] = *(const u32x4*)(rp + 3072 + g * 128 + c_cb); rb[k] = *(const u32x4*)(rp + 2048 + g * 128 + c_cb); }
                rx = __builtin_nontemporal_load((const u32x4*)(act + (nb + r_x) * 4096 + hh * 64 + c_x));
                if (tid < 64) { rct = ctv[(nb + tid) * 32 + hh]; rdt = dtv[(nb + tid) * 32 + hh]; }
            }
            const float ct63 = ctl[63];
#pragma unroll
            for (int k = 0; k < 2; ++k) {
                const int idx = tid + NT * k, n = idx & 127, s8 = idx >> 7;
                uint32_t v[8];
#pragma unroll
                for (int j = 0; j < 8; ++j) v[j] = *(const LAS bf16_t*)(lds + SC_BS + ((s8 * 8 + j) * 136 + n) * 2);
                *(LAS u32x4*)(lds + SC_BT + (n * 72 + s8 * 8) * 2) = (u32x4){v[0] | (v[1] << 16), v[2] | (v[3] << 16), v[4] | (v[5] << 16), v[6] | (v[7] << 16)};
            }
            {
                const int p = tid & 63, s8 = tid >> 6;
                float a[8], d[8];
#pragma unroll
                for (int j = 0; j < 8; ++j) { const int s_ = s8 * 8 + j; a[j] = lds_bf(lds + SC_XR, s_ * 72 + p) * dtl[s_]; d[j] = a[j] * __expf(ct63 - ctl[s_]); }
                u32x4 o; o.x = pg8::cvt_pk_bf16(a[0], a[1]); o.y = pg8::cvt_pk_bf16(a[2], a[3]); o.z = pg8::cvt_pk_bf16(a[4], a[5]); o.w = pg8::cvt_pk_bf16(a[6], a[7]);
                *(LAS u32x4*)(lds + SC_XT + (p * 72 + s8 * 8) * 2) = o;
                o.x = pg8::cvt_pk_bf16(d[0], d[1]); o.y = pg8::cvt_pk_bf16(d[2], d[3]); o.z = pg8::cvt_pk_bf16(d[4], d[5]); o.w = pg8::cvt_pk_bf16(d[6], d[7]);
                *(LAS u32x4*)(lds + SC_XD + (p * 72 + s8 * 8) * 2) = o;
            }
            __syncthreads();
            const int mi = w >> 1, nb2 = (w & 1) * 2;
            {
                f32x4 acc[2] = { (f32x4){0.f, 0.f, 0.f, 0.f}, (f32x4){0.f, 0.f, 0.f, 0.f} };
                mma_2tiles<4>(acc, lds + SC_BS, mi * 16 + l15, 136, lds + SC_CS, nb2 * 16 + l15, nb2 * 16 + 16 + l15, 136, quad);
                const int s0 = mi * 16 + quad * 4;
#pragma unroll
                for (int ni = 0; ni < 2; ++ni) {
                    const int t = (nb2 + ni) * 16 + l15; const float ctt = ctl[t];
                    float pv[4];
#pragma unroll
                    for (int j = 0; j < 4; ++j) pv[j] = (s0 + j <= t) ? acc[ni][j] * __expf(ctt - ctl[s0 + j]) : 0.f;
                    *(LAS u32x2*)(lds + SC_PS + (t * 72 + s0) * 2) = pack_bf4(pv[0], pv[1], pv[2], pv[3]);
                }
            }
            f32x4 yacc[2] = { (f32x4){0.f, 0.f, 0.f, 0.f}, (f32x4){0.f, 0.f, 0.f, 0.f} };
            mma_2tiles<4>(yacc, lds + SC_ST, mi * 16 + l15, 136, lds + SC_CS, nb2 * 16 + l15, nb2 * 16 + 16 + l15, 136, quad);
#pragma unroll
            for (int ni = 0; ni < 2; ++ni) yacc[ni] *= __expf(ctl[(nb2 + ni) * 16 + l15]);
            __syncthreads();
            mma_2tiles<2>(yacc, lds + SC_XT, mi * 16 + l15, 72, lds + SC_PS, nb2 * 16 + l15, nb2 * 16 + 16 + l15, 72, quad);
#pragma unroll
            for (int ni = 0; ni < 2; ++ni) {
                const int t = (nb2 + ni) * 16 + l15, p0 = mi * 16 + quad * 4;
                const u32x2 xr = *(const LAS u32x2*)(lds + SC_XR + (t * 72 + p0) * 2);
                f32x4 o = yacc[ni];
                o[0] += Dk * __uint_as_float(xr.x << 16); o[1] += Dk * __uint_as_float(xr.x & 0xffff0000u); o[2] += Dk * __uint_as_float(xr.y << 16); o[3] += Dk * __uint_as_float(xr.y & 0xffff0000u);
                __builtin_nontemporal_store(o, (f32x4*)(ymix + (rowbase + t) * 2048 + hh * 64 + p0));
            }
            {
                const float e63 = __expf(ct63);
#pragma unroll
                for (int ni = 0; ni < 4; ++ni) Sacc[ni] *= e63;
                mma_state<1>(*(f32x4 (*)[1][4])&Sacc, lds + SC_BT, w * 16, 72, lds + SC_XD, 72, l15, quad);
            }
            __syncthreads();
#pragma unroll
            for (int ni = 0; ni < 4; ++ni) *(LAS u32x2*)(lds + SC_ST + ((ni * 16 + l15) * 136 + w * 16 + quad * 4) * 2) = pack_bf4(Sacc[ni][0], Sacc[ni][1], Sacc[ni][2], Sacc[ni][3]);
        }
#pragma unroll
        for (int ni = 0; ni < 4; ++ni) __builtin_nontemporal_store(Sacc[ni], (f32x4*)(p_out + (((size_t)b * 32 + hh) * 64 + ni * 16 + l15) * 128 + w * 16 + quad * 4));
        __syncthreads();
    }
}

__device__ __forceinline__ void k_ret_pre(unsigned char* lds, const int bid, const int G, const bf16_t* __restrict__ proj, const float* __restrict__ rope, bf16_t* __restrict__ qk) {
    const int tid = opaque_tid(), lane = tid & 63, w = tid >> 6;
    for (int row = bid * 8 + w; row < T; row += 2 * G * 8) {
        const int rowB = row + G * 8; const bool hasB = rowB < T; const int rB = hasB ? rowB : row;
        uint32_t xa[2][8], xb_[2][8]; float4 cs[2];
#pragma unroll
        for (int q = 0; q < 2; ++q) {
            const int r = q ? rB : row;
            const int prow = (r < TP) ? (r & (PL - 1)) : PL + ((r - TP) & (SL - 1));
            cs[q] = *(const float4*)(rope + ((size_t)prow * 128 + lane * 2) * 2);
            const uint32_t* src = (const uint32_t*)(proj + (size_t)r * NIN);
#pragma unroll
            for (int hd = 0; hd < 8; ++hd) { xa[q][hd] = __builtin_nontemporal_load(src + hd * 128 + lane); xb_[q][hd] = __builtin_nontemporal_load(src + hd * 128 + 64 + lane); }
        }
#pragma unroll
        for (int q = 0; q < 2; ++q) {
            if (q == 1 && !hasB) break;
            uint32_t* dst = (uint32_t*)(qk + (size_t)(q ? rowB : row) * 4096);
#pragma unroll
            for (int hd = 0; hd < 8; ++hd) {
                const uint32_t a = xa[q][hd], b = xb_[q][hd];
                const float x1a = __uint_as_float(a << 16), x1b = __uint_as_float(a & 0xffff0000u), x2a = __uint_as_float(b << 16), x2b = __uint_as_float(b & 0xffff0000u);
                const float sc = (hd < 4) ? 1.f : 0.0625f;
                dst[hd * 128 + lane] = pack_bf2((x1a * cs[q].x - x2a * cs[q].y) * sc, (x1b * cs[q].z - x2b * cs[q].w) * sc);
                dst[hd * 128 + 64 + lane] = pack_bf2((x1a * cs[q].y + x2a * cs[q].x) * sc, (x1b * cs[q].w + x2b * cs[q].z) * sc);
            }
        }
    }
}

constexpr int RC_QS = 0, RC_KS = RC_QS + 64 * 264 * 2, RC_KT = RC_KS + 64 * 264 * 2, RC_VT = RC_KT + 256 * 72 * 2, RC_ST = RC_VT + 64 * 72 * 2, RC_PS = RC_ST + 64 * 264 * 2, RC_END = RC_PS + 64 * 72 * 2, RC_GP = RC_END;
__device__ __forceinline__ void k_ret_chunk(unsigned char* lds_, const int bid, const int G, const bf16_t* __restrict__ qk, const bf16_t* __restrict__ proj, float* __restrict__ ymix, float* __restrict__ p_out) {
    LAS unsigned char* lds = (LAS unsigned char*)lds_;
    const int tid = opaque_tid(), lane = tid & 63, w = __builtin_amdgcn_readfirstlane(tid >> 6), l15 = lane & 15, quad = lane >> 4;
    for (int unit = bid; unit < NPB * 32; unit += G) {
        const int un = xcd_unit(unit, G), b = un >> 5, h = (un >> 3) & 3, sl = un & 7;
        const float lg = log2f(1.f - exp2f(-5.f - (float)h));
        f32x4 Sacc[2][4];
#pragma unroll
        for (int i = 0; i < 2; ++i)
#pragma unroll
            for (int j = 0; j < 4; ++j) Sacc[i][j] = (f32x4){0.f, 0.f, 0.f, 0.f};
        for (int i = tid; i < 64 * 264 / 8; i += NT) *(LAS u32x4*)(lds + RC_ST + i * 16) = (u32x4){0u, 0u, 0u, 0u};
        LAS float* gpw = (LAS float*)(lds + RC_GP);
        if (tid < 65) gpw[tid] = __builtin_amdgcn_exp2f((float)tid * lg);
        u32x4 rq[4], rk[4], rv;
        const int r_qk = tid >> 5, c_qk = (tid & 31) * 8;
        const int r_v = tid >> 3, c_v = (tid & 7) * 8;
        {
            const size_t rowbase = (size_t)b * PL;
#pragma unroll
            for (int k = 0; k < 4; ++k) { const bf16_t* rp = qk + (rowbase + r_qk + 16 * k) * 4096 + h * 256 + c_qk; rq[k] = *(const u32x4*)rp; rk[k] = *(const u32x4*)(rp + 1024); }
            rv = __builtin_nontemporal_load((const u32x4*)(proj + (rowbase + r_v) * NIN + 2048 + h * 512 + sl * 64 + c_v));
        }
        for (int c = 0; c < 32; ++c) {
            const size_t rowbase = (size_t)b * PL + c * 64;
#pragma unroll
            for (int k = 0; k < 4; ++k) { *(LAS u32x4*)(lds + RC_QS + ((r_qk + 16 * k) * 264 + c_qk) * 2) = rq[k]; *(LAS u32x4*)(lds + RC_KS + ((r_qk + 16 * k) * 264 + c_qk) * 2) = rk[k]; }
            *(LAS u32x4*)(lds + RC_PS + (r_v * 72 + c_v) * 2) = rv;
            __syncthreads();
            if (c + 1 < 32) {
                const size_t nb = rowbase + 64;
#pragma unroll
                for (int k = 0; k < 4; ++k) { const bf16_t* rp = qk + (nb + r_qk + 16 * k) * 4096 + h * 256 + c_qk; rq[k] = *(const u32x4*)rp; rk[k] = *(const u32x4*)(rp + 1024); }
                rv = __builtin_nontemporal_load((const u32x4*)(proj + (nb + r_v) * NIN + 2048 + h * 512 + sl * 64 + c_v));
            }
            int tz = tid; asm volatile("" : "+v"(tz));
            const int l15z = tz & 15, quadz = (tz & 63) >> 4;
#pragma unroll
            for (int k = 0; k < 4; ++k) {
                const int idx = tz + NT * k, d = idx & 255, s8 = idx >> 8;
                float a[8];
#pragma unroll
                for (int j = 0; j < 8; ++j) a[j] = lds_bf(lds + RC_KS, (s8 * 8 + j) * 264 + d) * gpw[63 - s8 * 8 - j];
                u32x4 o; o.x = pg8::cvt_pk_bf16(a[0], a[1]); o.y = pg8::cvt_pk_bf16(a[2], a[3]); o.z = pg8::cvt_pk_bf16(a[4], a[5]); o.w = pg8::cvt_pk_bf16(a[6], a[7]);
                *(LAS u32x4*)(lds + RC_KT + (d * 72 + s8 * 8) * 2) = o;
            }
            {
                const int v = tz & 63, s8 = tz >> 6;
                uint32_t x[8];
#pragma unroll
                for (int j = 0; j < 8; ++j) x[j] = *(const LAS bf16_t*)(lds + RC_PS + ((s8 * 8 + j) * 72 + v) * 2);
                *(LAS u32x4*)(lds + RC_VT + (v * 72 + s8 * 8) * 2) = (u32x4){x[0] | (x[1] << 16), x[2] | (x[3] << 16), x[4] | (x[5] << 16), x[6] | (x[7] << 16)};
            }
            __syncthreads();
            const int mi = w >> 1, nb2 = (w & 1) * 2;
            {
                f32x4 acc[2] = { (f32x4){0.f, 0.f, 0.f, 0.f}, (f32x4){0.f, 0.f, 0.f, 0.f} };
                mma_2tiles<8>(acc, lds + RC_KS, mi * 16 + l15, 264, lds + RC_QS, nb2 * 16 + l15, nb2 * 16 + 16 + l15, 264, quad);
                const int s0 = mi * 16 + quadz * 4;
#pragma unroll
                for (int ni = 0; ni < 2; ++ni) {
                    const int t = (nb2 + ni) * 16 + l15z;
                    float pv[4];
#pragma unroll
                    for (int j = 0; j < 4; ++j) pv[j] = (s0 + j <= t) ? acc[ni][j] * gpw[t - s0 - j] : 0.f;
                    *(LAS u32x2*)(lds + RC_PS + (t * 72 + s0) * 2) = pack_bf4(pv[0], pv[1], pv[2], pv[3]);
                }
            }
            f32x4 yacc[2] = { (f32x4){0.f, 0.f, 0.f, 0.f}, (f32x4){0.f, 0.f, 0.f, 0.f} };
            mma_2tiles<8>(yacc, lds + RC_ST, mi * 16 + l15, 264, lds + RC_QS, nb2 * 16 + l15, nb2 * 16 + 16 + l15, 264, quad);
#pragma unroll
            for (int ni = 0; ni < 2; ++ni) yacc[ni] *= gpw[(nb2 + ni) * 16 + l15z + 1];
            __syncthreads();
            mma_2tiles<2>(yacc, lds + RC_VT, mi * 16 + l15, 72, lds + RC_PS, nb2 * 16 + l15, nb2 * 16 + 16 + l15, 72, quad);
#pragma unroll
            for (int ni = 0; ni < 2; ++ni) __builtin_nontemporal_store(yacc[ni], (f32x4*)(ymix + (rowbase + (nb2 + ni) * 16 + l15) * 2048 + h * 512 + sl * 64 + mi * 16 + quad * 4));
            {
                const float e64 = gpw[64];
#pragma unroll
                for (int m2 = 0; m2 < 2; ++m2)
#pragma unroll
                    for (int ni = 0; ni < 4; ++ni) Sacc[m2][ni] *= e64;
                mma_state<2>(Sacc, lds + RC_KT, 2 * w * 16, 72, lds + RC_VT, 72, l15, quad);
            }
            __syncthreads();
#pragma unroll
            for (int m2 = 0; m2 < 2; ++m2)
#pragma unroll
                for (int ni = 0; ni < 4; ++ni)
                    *(LAS u32x2*)(lds + RC_ST + ((ni * 16 + l15) * 264 + (2 * w + m2) * 16 + quad * 4) * 2) = pack_bf4(Sacc[m2][ni][0], Sacc[m2][ni][1], Sacc[m2][ni][2], Sacc[m2][ni][3]);
        }
#pragma unroll
        for (int m2 = 0; m2 < 2; ++m2)
#pragma unroll
            for (int ni = 0; ni < 4; ++ni)
#pragma unroll
                for (int j = 0; j < 4; ++j)
                    __builtin_nontemporal_store(Sacc[m2][ni][j], p_out + (((size_t)b * 4 + h) * 256 + (2 * w + m2) * 16 + quad * 4 + j) * 512 + sl * 64 + ni * 16 + l15);
        __syncthreads();
    }
}

constexpr int GA_HALF = 71424, GA_KS = 0, GA_QS = 17408, GA_LM = 34816, GA_GC = 52224, GA_BE = 52480, GA_E63 = 52736, GA_EGC = 52992, GA_BEG = 53248, GA_VS = 53504;
__device__ __forceinline__ void k_gdn_p2a(unsigned char* lds_, const int bid, const int G, const bf16_t* __restrict__ act, const float* __restrict__ betav, const float* __restrict__ gv,
                                          bf16_t* __restrict__ Ug, bf16_t* __restrict__ Wg, bf16_t* __restrict__ Qdg, bf16_t* __restrict__ KdTg, bf16_t* __restrict__ Atg) {
    const int tid = opaque_tid(), half = __builtin_amdgcn_readfirstlane(tid >> 8), ht = tid & 255, lane = tid & 63, wh = __builtin_amdgcn_readfirstlane((tid >> 6) & 3), l15 = lane & 15, quad = lane >> 4;
    LAS unsigned char* lds = (LAS unsigned char*)lds_ + half * GA_HALF;
    LAS float* gcl = (LAS float*)(lds + GA_GC); LAS float* bel = (LAS float*)(lds + GA_BE); LAS float* Lm = (LAS float*)(lds + GA_LM);
    LAS float* e63l = (LAS float*)(lds + GA_E63); LAS float* egcl = (LAS float*)(lds + GA_EGC); LAS float* begl = (LAS float*)(lds + GA_BEG);
    for (int u0 = bid * 2; u0 < NPB * 16 * 32; u0 += G * 2) {
        const int unit = u0 + half, chunk = unit & 31, hv = (unit >> 5) & 15, b = unit >> 9, hk = hv >> 1;
        const size_t rowbase = (size_t)b * PL + chunk * 64;
        __syncthreads();
#pragma unroll
        for (int k = 0; k < 4; ++k) {
            const int idx = ht + 256 * k, r = idx >> 4, c8 = (idx & 15) * 8;
            const bf16_t* rp = act + (rowbase + r) * 4096 + hk * 128 + c8;
            *(LAS u32x4*)(lds + GA_QS + (r * 136 + c8) * 2) = *(const u32x4*)rp;
            *(LAS u32x4*)(lds + GA_KS + (r * 136 + c8) * 2) = *(const u32x4*)(rp + 1024);
            *(LAS u32x4*)(lds + GA_VS + (r * 136 + c8) * 2) = __builtin_nontemporal_load((const u32x4*)(act + (rowbase + r) * 4096 + 2048 + hv * 128 + c8));
        }
        if (ht < 64) { const float gch = gv[(rowbase + ht) * 32 + 16 + hv], bt = betav[(rowbase + ht) * 16 + hv], g63h = gv[(rowbase + 63) * 32 + 16 + hv], eg = __expf(gch);
            gcl[ht] = gch; bel[ht] = bt; e63l[ht] = __expf(g63h - gch); egcl[ht] = eg; begl[ht] = bt * eg; }
        __syncthreads();
        {
            f32x4 akk[4], aqk[4];
#pragma unroll
            for (int ni = 0; ni < 4; ++ni) { akk[ni] = (f32x4){0.f, 0.f, 0.f, 0.f}; aqk[ni] = (f32x4){0.f, 0.f, 0.f, 0.f}; }
#pragma unroll
            for (int kh = 0; kh < 2; ++kh) {
                bf16x8 fa[2], fk[2][4], fq[2][4];
#pragma unroll
                for (int ks = 0; ks < 2; ++ks) { const int k = (kh * 2 + ks) * 32 + quad * 8; fa[ks] = ld_frag(lds + GA_KS, wh * 16 + l15, 136, k);
#pragma unroll
                    for (int ni = 0; ni < 4; ++ni) { fk[ks][ni] = ld_frag(lds + GA_KS, ni * 16 + l15, 136, k); fq[ks][ni] = ld_frag(lds + GA_QS, ni * 16 + l15, 136, k); } }
                __builtin_amdgcn_sched_barrier(0);
#pragma unroll
                for (int ks = 0; ks < 2; ++ks)
#pragma unroll
                    for (int ni = 0; ni < 4; ++ni) { akk[ni] = MFMA16(fa[ks], fk[ks][ni], akk[ni]); aqk[ni] = MFMA16(fa[ks], fq[ks][ni], aqk[ni]); }
                __builtin_amdgcn_sched_barrier(0);
            }
            const int s0 = wh * 16 + quad * 4;
#pragma unroll
            for (int ni = 0; ni < 4; ++ni) {
                const int t = ni * 16 + l15; const float gt = gcl[t], bt = bel[t];
                float lv[4], av[4];
#pragma unroll
                for (int j = 0; j < 4; ++j) { const float e = __expf(gt - gcl[s0 + j]); lv[j] = (s0 + j < t) ? bt * akk[ni][j] * e : 0.f; av[j] = (s0 + j <= t) ? aqk[ni][j] * e : 0.f; }
                *(LAS f32x4*)(Lm + t * 68 + s0) = (f32x4){lv[0], lv[1], lv[2], lv[3]};
                *(u32x2*)(Atg + ((size_t)unit * 64 + t) * 64 + s0) = pack_bf4(av[0], av[1], av[2], av[3]);
            }
        }
        {
#pragma unroll
            for (int k = 0; k < 4; ++k) {
                const int idx = ht + 256 * k, t = idx >> 4, c8 = (idx & 15) * 8;
                float f[8]; const u32x4 raw = *(const LAS u32x4*)(lds + GA_QS + (t * 136 + c8) * 2);
                unpack_bf8(make_uint4(raw.x, raw.y, raw.z, raw.w), f);
                const float e = egcl[t];
                u32x4 o; o.x = pg8::cvt_pk_bf16(f[0] * e, f[1] * e); o.y = pg8::cvt_pk_bf16(f[2] * e, f[3] * e); o.z = pg8::cvt_pk_bf16(f[4] * e, f[5] * e); o.w = pg8::cvt_pk_bf16(f[6] * e, f[7] * e);
                *(u32x4*)(Qdg + ((size_t)unit * 64 + t) * 128 + c8) = o;
            }
#pragma unroll
            for (int k = 0; k < 4; ++k) {
                const int idx = ht + 256 * k, d = idx & 127, s8 = idx >> 7;
                float a[8];
#pragma unroll
                for (int j = 0; j < 8; ++j) a[j] = lds_bf(lds + GA_KS, (s8 * 8 + j) * 136 + d) * e63l[s8 * 8 + j];
                u32x4 o; o.x = pg8::cvt_pk_bf16(a[0], a[1]); o.y = pg8::cvt_pk_bf16(a[2], a[3]); o.z = pg8::cvt_pk_bf16(a[4], a[5]); o.w = pg8::cvt_pk_bf16(a[6], a[7]);
                *(u32x4*)(KdTg + ((size_t)unit * 128 + d) * 64 + s8 * 8) = o;
            }
        }
        float x[64];
        if (ht < 128) {
#pragma unroll
            for (int t = 0; t < 64; ++t) x[t] = bel[t] * lds_bf(lds + GA_VS, t * 136 + ht);
        } else {
#pragma unroll
            for (int t = 0; t < 64; ++t) x[t] = begl[t] * lds_bf(lds + GA_KS, t * 136 + ht - 128);
        }
        __syncthreads();
#pragma unroll
        for (int t = 1; t < 64; ++t) {
            f32x4 l[16];
#pragma unroll
            for (int q = 0; q < (t + 3) / 4; ++q) l[q] = *(const LAS f32x4*)(Lm + t * 68 + q * 4);
            __builtin_amdgcn_sched_barrier(0);
            float a0 = x[t], a1 = 0.f, a2 = 0.f, a3 = 0.f;
#pragma unroll
            for (int q = 0; q < (t + 3) / 4; ++q) { a0 -= l[q][0] * x[4 * q]; a1 -= l[q][1] * x[4 * q + 1]; a2 -= l[q][2] * x[4 * q + 2]; a3 -= l[q][3] * x[4 * q + 3]; }
            x[t] = (a0 + a1) + (a2 + a3);
            __builtin_amdgcn_sched_barrier(0);
        }
        {
            LAS unsigned char* stg = lds + ((ht < 128) ? GA_QS : GA_KS); const int cc = ht & 127;
#pragma unroll
            for (int t = 0; t < 64; ++t) *(LAS bf16_t*)(stg + (t * 136 + cc) * 2) = f2bf(x[t]);
            __syncthreads();
#pragma unroll
            for (int k = 0; k < 4; ++k) {
                const int idx = ht + 256 * k, r = idx >> 4, c8 = (idx & 15) * 8;
                __builtin_nontemporal_store(*(const LAS u32x4*)(lds + GA_QS + (r * 136 + c8) * 2), (u32x4*)(Ug + ((size_t)unit * 64 + r) * 128 + c8));
                *(u32x4*)(Wg + ((size_t)unit * 64 + r) * 128 + c8) = *(const LAS u32x4*)(lds + GA_KS + (r * 136 + c8) * 2);
            }
        }
    }
}

constexpr int GB_WS = 0, GB_QD = GB_WS + 64 * 136 * 2, GB_KT = GB_QD + 64 * 136 * 2, GB_AT = GB_KT + 128 * 72 * 2, GB_US = GB_AT + 64 * 72 * 2, GB_ST = GB_US + 64 * 72 * 2, GB_VN = GB_ST + 64 * 136 * 2, GB_END = GB_VN + 64 * 72 * 2;
__device__ __forceinline__ void k_gdn_p2b(unsigned char* lds_, const int bid, const int G, const bf16_t* __restrict__ Ug, const bf16_t* __restrict__ Wg, const bf16_t* __restrict__ Qdg, const bf16_t* __restrict__ KdTg,
                                          const bf16_t* __restrict__ Atg, const float* __restrict__ gv, float* __restrict__ ymix, float* __restrict__ p_out) {
    LAS unsigned char* lds = (LAS unsigned char*)lds_;
    const int tid = opaque_tid(), lane = tid & 63, w = __builtin_amdgcn_readfirstlane(tid >> 6), l15 = lane & 15, quad = lane >> 4;
    for (int unit = bid; unit < NPB * 32; unit += G) {
        const int un = xcd_unit(unit, G), b = un >> 5, hv = (un >> 1) & 15, vh = un & 1;
        f32x4 Sacc[4];
#pragma unroll
        for (int i = 0; i < 4; ++i) Sacc[i] = (f32x4){0.f, 0.f, 0.f, 0.f};
        for (int i = tid; i < 64 * 136 / 8; i += NT) *(LAS u32x4*)(lds + GB_ST + i * 16) = (u32x4){0u, 0u, 0u, 0u};
        u32x4 rw[2], rqd[2], rkt[2], rat, ru;
        const int r_a = tid >> 4, c_a = (tid & 15) * 8;
        const int r_k = tid >> 3, c_k = (tid & 7) * 8;
        const size_t ua0 = ((size_t)b * 16 + hv) * 32;
        {
#pragma unroll
            for (int k = 0; k < 2; ++k) {
                rw[k] = *(const u32x4*)(Wg + (ua0 * 64 + r_a + 32 * k) * 128 + c_a); rqd[k] = *(const u32x4*)(Qdg + (ua0 * 64 + r_a + 32 * k) * 128 + c_a);
                rkt[k] = *(const u32x4*)(KdTg + (ua0 * 128 + r_k + 64 * k) * 64 + c_k);
            }
            rat = *(const u32x4*)(Atg + (ua0 * 64 + r_k) * 64 + c_k);
            ru = __builtin_nontemporal_load((const u32x4*)(Ug + (ua0 * 64 + r_k) * 128 + vh * 64 + c_k));
        }
        for (int c = 0; c < 32; ++c) {
            const size_t rowbase = (size_t)b * PL + c * 64;
#pragma unroll
            for (int k = 0; k < 2; ++k) {
                *(LAS u32x4*)(lds + GB_WS + ((r_a + 32 * k) * 136 + c_a) * 2) = rw[k]; *(LAS u32x4*)(lds + GB_QD + ((r_a + 32 * k) * 136 + c_a) * 2) = rqd[k];
                *(LAS u32x4*)(lds + GB_KT + ((r_k + 64 * k) * 72 + c_k) * 2) = rkt[k];
            }
            *(LAS u32x4*)(lds + GB_AT + (r_k * 72 + c_k) * 2) = rat;
            *(LAS u32x4*)(lds + GB_US + (r_k * 72 + c_k) * 2) = ru;
            __syncthreads();
            if (c + 1 < 32) {
                const size_t ua = ua0 + c + 1;
#pragma unroll
                for (int k = 0; k < 2; ++k) {
                    rw[k] = *(const u32x4*)(Wg + (ua * 64 + r_a + 32 * k) * 128 + c_a); rqd[k] = *(const u32x4*)(Qdg + (ua * 64 + r_a + 32 * k) * 128 + c_a);
                    rkt[k] = *(const u32x4*)(KdTg + (ua * 128 + r_k + 64 * k) * 64 + c_k);
                }
                rat = *(const u32x4*)(Atg + (ua * 64 + r_k) * 64 + c_k);
                ru = __builtin_nontemporal_load((const u32x4*)(Ug + (ua * 64 + r_k) * 128 + vh * 64 + c_k));
            }
            const int mi = w >> 1, nb2 = (w & 1) * 2;
            f32x4 oacc[2] = { (f32x4){0.f, 0.f, 0.f, 0.f}, (f32x4){0.f, 0.f, 0.f, 0.f} };
            {
                f32x4 acc[2] = { (f32x4){0.f, 0.f, 0.f, 0.f}, (f32x4){0.f, 0.f, 0.f, 0.f} };
                mma_2tiles<4>(acc, lds + GB_WS, mi * 16 + l15, 136, lds + GB_ST, nb2 * 16 + l15, nb2 * 16 + 16 + l15, 136, quad);
                mma_2tiles<4>(oacc, lds + GB_ST, mi * 16 + l15, 136, lds + GB_QD, nb2 * 16 + l15, nb2 * 16 + 16 + l15, 136, quad);
                const int t0 = mi * 16 + quad * 4;
#pragma unroll
                for (int ni = 0; ni < 2; ++ni) {
                    const int v = (nb2 + ni) * 16 + l15;
                    float vn[4];
#pragma unroll
                    for (int j = 0; j < 4; ++j) vn[j] = lds_bf(lds + GB_US, (t0 + j) * 72 + v) - acc[ni][j];
                    *(LAS u32x2*)(lds + GB_VN + (v * 72 + t0) * 2) = pack_bf4(vn[0], vn[1], vn[2], vn[3]);
                }
            }
            __syncthreads();
            mma_2tiles<2>(oacc, lds + GB_VN, mi * 16 + l15, 72, lds + GB_AT, nb2 * 16 + l15, nb2 * 16 + 16 + l15, 72, quad);
#pragma unroll
            for (int ni = 0; ni < 2; ++ni) __builtin_nontemporal_store(oacc[ni], (f32x4*)(ymix + (rowbase + (nb2 + ni) * 16 + l15) * 2048 + hv * 128 + vh * 64 + mi * 16 + quad * 4));
            {
                const float e63 = __expf(gv[(rowbase + 63) * 32 + 16 + hv]);
#pragma unroll
                for (int ni = 0; ni < 4; ++ni) Sacc[ni] *= e63;
                mma_state<1>(*(f32x4 (*)[1][4])&Sacc, lds + GB_KT, w * 16, 72, lds + GB_VN, 72, l15, quad);
            }
            __syncthreads();
#pragma unroll
            for (int ni = 0; ni < 4; ++ni) *(LAS u32x2*)(lds + GB_ST + ((ni * 16 + l15) * 136 + w * 16 + quad * 4) * 2) = pack_bf4(Sacc[ni][0], Sacc[ni][1], Sacc[ni][2], Sacc[ni][3]);
        }
#pragma unroll
        for (int ni = 0; ni < 4; ++ni)
#pragma unroll
            for (int j = 0; j < 4; ++j) __builtin_nontemporal_store(Sacc[ni][j], p_out + (((size_t)b * 16 + hv) * 128 + w * 16 + quad * 4 + j) * 128 + vh * 64 + ni * 16 + l15);
        __syncthreads();
    }
}

template <int EPI, int BN, int BK>
__device__ __forceinline__ void k_gemm_small(unsigned char* lds_, const int bid, const int G, const bf16_t* __restrict__ A, const bf16_t* __restrict__ Bt, const int N, const int K,
                                             const float* __restrict__ base, float* __restrict__ outf, bf16_t* __restrict__ outb, const pg8::SsqRef ssq) {
    constexpr int LDK = BK + 8, NT16 = BN / 32, CPR = BK / 8  , RPP = NT / CPR  , NA = 64 / RPP, NB = BN / RPP;
    constexpr int GS_AS = 0, GS_BS = 64 * LDK * 2;
    static_assert(GS_BS + BN * LDK * 2 <= 131072, "small gemm LDS");
    LAS unsigned char* lds = (LAS unsigned char*)lds_;
    const int tid = opaque_tid(), lane = tid & 63, w = __builtin_amdgcn_readfirstlane(tid >> 6), l15 = lane & 15, quad = lane >> 4;
    const int mi = w >> 1, ng = w & 1;
    const int r_t = tid / CPR, c_t = (tid % CPR) * 8;
    for (int item = bid; item < 8 * (N / BN); item += G) {
        const int mt = item & 7, nt = item >> 3;
        const bf16_t* Ap = A + (size_t)(mt * 64 + r_t) * K + c_t;
        const bf16_t* Bp = Bt + (size_t)(nt * BN + r_t) * K + c_t;
        u32x4 ra[NA], rb[NB];
#pragma unroll
        for (int k = 0; k < NA; ++k) ra[k] = *(const u32x4*)(Ap + (size_t)RPP * k * K);
#pragma unroll
        for (int k = 0; k < NB; ++k) rb[k] = *(const u32x4*)(Bp + (size_t)RPP * k * K);
        float rsv[4] = {1.f, 1.f, 1.f, 1.f};
        if (EPI == 1) {
#pragma unroll
            for (int j = 0; j < 4; ++j) rsv[j] = pg8::row_rs(ssq, TP + mt * 64 + mi * 16 + quad * 4 + j);
        }
        f32x4 acc[NT16];
#pragma unroll
        for (int n = 0; n < NT16; ++n) acc[n] = (f32x4){0.f, 0.f, 0.f, 0.f};
        for (int k0 = 0; k0 < K; k0 += BK) {
            __syncthreads();
#pragma unroll
            for (int k = 0; k < NA; ++k) *(LAS u32x4*)(lds + GS_AS + ((r_t + RPP * k) * LDK + c_t) * 2) = ra[k];
#pragma unroll
            for (int k = 0; k < NB; ++k) *(LAS u32x4*)(lds + GS_BS + ((r_t + RPP * k) * LDK + c_t) * 2) = rb[k];
            __syncthreads();
            if (k0 + BK < K) {
#pragma unroll
                for (int k = 0; k < NA; ++k) ra[k] = *(const u32x4*)(Ap + (size_t)RPP * k * K + k0 + BK);
#pragma unroll
                for (int k = 0; k < NB; ++k) rb[k] = *(const u32x4*)(Bp + (size_t)RPP * k * K + k0 + BK);
            }
#pragma unroll
            for (int kb = 0; kb < BK / 128; ++kb) {
                bf16x8 fa[4], fb[4][NT16];
#pragma unroll
                for (int ks = 0; ks < 4; ++ks) { const int k = (kb * 4 + ks) * 32 + quad * 8; fa[ks] = ld_frag(lds + GS_AS, mi * 16 + l15, LDK, k);
#pragma unroll
                    for (int n = 0; n < NT16; ++n) fb[ks][n] = ld_frag(lds + GS_BS, (ng * NT16 + n) * 16 + l15, LDK, k); }
                __builtin_amdgcn_sched_barrier(0);
#pragma unroll
                for (int ks = 0; ks < 4; ++ks)
#pragma unroll
                    for (int n = 0; n < NT16; ++n) acc[n] = MFMA16(fa[ks], fb[ks][n], acc[n]);
                __builtin_amdgcn_sched_barrier(0);
            }
        }
#pragma unroll
        for (int j = 0; j < 4; ++j) {
            const int row = mt * 64 + mi * 16 + quad * 4 + j;
            float ss = 0.f;
#pragma unroll
            for (int n = 0; n < NT16; ++n) {
                const size_t o = (size_t)row * N + nt * BN + (ng * NT16 + n) * 16 + l15;
                if (EPI == 0) { const float x = __builtin_nontemporal_load(base + o) + acc[n][j]; __builtin_nontemporal_store(x, outf + o); outb[o] = f2bf(x); ss += x * x; }
                else { const float r = fmaxf(acc[n][j], 0.f) * rsv[j]; outb[o] = f2bf(r * r); }
            }
            if (EPI == 0) {
                ss = row16_sum(ss);
                if (l15 == 0) ssq.p64[(size_t)row * 64 + nt * 2 + ng] = ss;
            }
        }
    }
}

constexpr int LDS_BYTES = 156672 + 1024;
constexpr int RST_OFF = 131072;

#define GRID_BAR() do { REPEAT(REP_BAR) xcd_barrier(xbar); } while (0)

__device__ __forceinline__ pg8::SsqRef ssq_ref(const P& p, int inst) { pg8::SsqRef r; r.p16 = p.ssq + (size_t)inst * TP * 16; r.p64 = p.ssq + (size_t)9 * TP * 16 + (size_t)inst * TS * 64; return r; }

template <int L>
__device__ __forceinline__ void layer_body(const P& p, unsigned char* lds, const int bid, const int G, const XcdBarrier& xbar) {
    constexpr int kind = L % 3, j = L / 3;
    REPEAT(REP_GEMM) {
    { pg8::Gemm g{p.xb, p.w_in[L], T, NIN, D}; pg8::StaticOrder S; S.init(T, NIN, G, bid); pg8::EpiProjS E{p.proj, NIN, (PG8_LAS unsigned char*)lds + RST_OFF};
      pg8::rs_table_build((PG8_LAS unsigned char*)lds + RST_OFF, S, ssq_ref(p, 2 * L), opaque_tid());
      pg8::gemm_phase<pg8::EpiProjS, pg8::StaticOrder>((PG8_LAS unsigned char*)lds, g, S, E, nullptr); }
    GRID_BAR(); }
    if (kind == 0) {
        REPEAT(REP_ELEM) { k_ret_pre(lds, bid, G, p.proj, p.rope, p.act); GRID_BAR(); }
        REPEAT(REP_CHUNK) k_ret_chunk(lds, bid, G, p.act, p.proj, p.ymix, p.out + O_PRET + (size_t)j * NPB * RET_ST);
        REPEAT(REP_SAMP) k_ret_scan(lds, bid, G, p.proj, p.act, p.in[2] + (size_t)j * NSB * RET_ST, p.ymix,
                   p.out + O_PRET + (size_t)j * NPB * RET_ST, p.out + O_SRET + (size_t)j * NSB * RET_ST);
        GRID_BAR();
        REPEAT(REP_ELEM) { k_gate<0>(lds, bid, G, p.ymix, p.proj, p.ab); GRID_BAR(); }
    } else if (kind == 1) {
        REPEAT(REP_ELEM) { k_conv_pre<1>(lds, bid, G, p.proj, p.in[4], p.in[13], p.in[14], p.in[15], p.in[16], p.act, p.sm1, p.sm2, p.out + O_PSSDC, p.out + O_SSSDC); GRID_BAR(); }
        REPEAT(REP_CHUNK) k_ssd_chunk(lds, bid, G, p.act, p.sm1, p.sm2, p.in[17], p.ymix, p.out + O_PSSD);
        REPEAT(REP_SAMP) k_ssd_scan(lds, bid, G, p.act, p.sm1, p.in[16], p.in[17], p.in[3], p.ymix, p.out + O_PSSD, p.out + O_SSSD);
        GRID_BAR();
        REPEAT(REP_ELEM) { k_gate<1>(lds, bid, G, p.ymix, p.proj, p.ab); GRID_BAR(); }
    } else {
        REPEAT(REP_ELEM) { k_conv_pre<2>(lds, bid, G, p.proj, p.in[6], p.in[21], nullptr, p.in[22], p.in[23], p.act, p.sm1, p.sm2, p.out + O_PGDNC, p.out + O_SGDNC); GRID_BAR(); }
        REPEAT(REP_CHUNK) k_gdn_p2a(lds, bid, G, p.act, p.sm1, p.sm2, p.gU, p.gW, p.gQd, p.gKdT, p.gAt);
        REPEAT(REP_SAMP) k_gdn_scan(lds, bid, G, p.act, p.sm1, p.sm2, p.in[5], p.ymix, p.out + O_PGDN, p.out + O_SGDN);
        GRID_BAR();
        REPEAT(REP_CHUNK) { k_gdn_p2b(lds, bid, G, p.gU, p.gW, p.gQd, p.gKdT, p.gAt, p.sm2, p.ymix, p.out + O_PGDN); GRID_BAR(); }
        REPEAT(REP_ELEM) { k_gate<2>(lds, bid, G, p.ymix, p.proj, p.ab); GRID_BAR(); }
    }
    REPEAT(REP_GEMM) {
    { pg8::Gemm g{p.ab, p.w_out[L], TP, D, 2048}; pg8::StaticOrder S; S.init(TP, D, G, bid); pg8::EpiResN E{p.xres, p.xres2, D, p.xb, ssq_ref(p, 2 * L + 1).p16};
      pg8::gemm_phase<pg8::EpiResN, pg8::StaticOrder>((PG8_LAS unsigned char*)lds, g, S, E, nullptr); }
    k_gemm_small<0, 32, 512>(lds, bid, G, p.ab + (size_t)TP * 2048, p.w_out[L], D, 2048, p.xres + (size_t)TP * D, p.xres2 + (size_t)TP * D, p.xb + (size_t)TP * D, ssq_ref(p, 2 * L + 1));
    GRID_BAR(); }
    REPEAT(REP_GEMM) {
    { pg8::Gemm g{p.xb, p.w_up[L], TP, DFF, D}; pg8::StaticOrder S; S.init(TP, DFF, G, bid); pg8::EpiSqrelu E{p.u, DFF, (PG8_LAS unsigned char*)lds + RST_OFF};
      pg8::rs_table_build((PG8_LAS unsigned char*)lds + RST_OFF, S, ssq_ref(p, 2 * L + 1), opaque_tid());
      pg8::gemm_phase<pg8::EpiSqrelu, pg8::StaticOrder>((PG8_LAS unsigned char*)lds, g, S, E, nullptr); }
    k_gemm_small<1, 128, 256>(lds, bid, G, p.xb + (size_t)TP * D, p.w_up[L], DFF, D, nullptr, nullptr, p.u + (size_t)TP * DFF, ssq_ref(p, 2 * L + 1));
    GRID_BAR(); }
    REPEAT(REP_GEMM) {
    { pg8::Gemm g{p.u, p.w_dn[L], TP, D, DFF}; pg8::StaticOrder S; S.init(TP, D, G, bid); pg8::EpiResN E{p.xres2, p.xres, D, p.xb, ssq_ref(p, 2 * L + 2).p16};
      pg8::gemm_phase<pg8::EpiResN, pg8::StaticOrder>((PG8_LAS unsigned char*)lds, g, S, E, nullptr); }
    k_gemm_small<0, 32, 512>(lds, bid, G, p.u + (size_t)TP * DFF, p.w_dn[L], D, DFF, p.xres2 + (size_t)TP * D, p.xres + (size_t)TP * D, p.xb + (size_t)TP * D, ssq_ref(p, 2 * L + 2));
    GRID_BAR(); }
}

__global__ void __launch_bounds__(NT, 2) mega_fwd(const P p) {
    extern __shared__ __attribute__((aligned(16))) unsigned char lds[];
    const int bid = blockIdx.x, G = gridDim.x;
    LAS unsigned* stw = (LAS unsigned*)(lds + LDS_BYTES - 16);
    if (threadIdx.x < 4) stw[threadIdx.x] = 0u;
    __syncthreads();
    const XcdBarrier xbar = xcd_barrier_post(p.bar, (volatile LAS unsigned*)stw);
    const float* norm_mix = p.in[7]; const float* norm_mlp = p.in[8];
    REPEAT(REP_P0) {
#pragma unroll
    for (int l = 0; l < 4; ++l) {
        const int kind = l % 3, j = l / 3;
        if (kind == 0) {
            k_prep_w(lds, bid, G, p.in[10] + (size_t)j * D * 6144, p.w_in[l], D, 6144, NIN, norm_mix + l * D, D);
            k_prep_w(lds, bid, G, p.in[11] + (size_t)j * 2048 * D, p.w_out[l], 2048, D, D, nullptr, 1);
        } else if (kind == 1) {
            k_prep_w(lds, bid, G, p.in[12], p.w_in[l], D, 6176, NIN, norm_mix + l * D, D);
            k_prep_w(lds, bid, G, p.in[19], p.w_out[l], 2048, D, D, p.in[18], 2048);
        } else {
            k_prep_w(lds, bid, G, p.in[20], p.w_in[l], D, 6176, NIN, norm_mix + l * D, D);
            k_prep_w(lds, bid, G, p.in[25], p.w_out[l], 2048, D, D, p.in[24], 128);
        }
        k_prep_w(lds, bid, G, p.in[26] + (size_t)l * D * DFF, p.w_up[l], D, DFF, DFF, norm_mlp + l * D, D);
        k_prep_w(lds, bid, G, p.in[27] + (size_t)l * DFF * D, p.w_dn[l], DFF, D, D, nullptr, 1);
    }
    k_rope(lds, bid, G, p.rope);
    k_x_prep(lds, bid, G, p.in[0], p.in[1], p.xres, p.xb, ssq_ref(p, 0));
    GRID_BAR(); }
    layer_body<0>(p, lds, bid, G, xbar);
    layer_body<1>(p, lds, bid, G, xbar);
    layer_body<2>(p, lds, bid, G, xbar);
    layer_body<3>(p, lds, bid, G, xbar);
    REPEAT(REP_ELEM) k_final_norm(lds, bid, G, p.xres, ssq_ref(p, 8), p.in[9], p.out);
}

static inline size_t al256(size_t x) { return (x + 255) & ~(size_t)255; }

extern "C" void kernel_launch(void* const* d_in, const int* in_sizes, int n_in, void* d_out, int out_size, void* d_ws, size_t ws_size, hipStream_t stream) {
    static int grid = 0;
    if (grid == 0) {
        int dev = 0, cus = 0, per_cu = 0;
        hipGetDevice(&dev);
        hipDeviceGetAttribute(&cus, hipDeviceAttributeMultiprocessorCount, dev);
        hipFuncSetAttribute((const void*)mega_fwd, hipFuncAttributeMaxDynamicSharedMemorySize, LDS_BYTES);
        hipOccupancyMaxActiveBlocksPerMultiprocessor(&per_cu, (const void*)mega_fwd, NT, LDS_BYTES);
        (void)hipGetLastError();
        if (cus <= 0) cus = 256;
        grid = cus;
    }
    P p{};
    for (int i = 0; i < 28; ++i) p.in[i] = (const float*)d_in[i];
    p.out = (float*)d_out;
    char* w = (char*)d_ws; size_t off = 65536;
    p.bar = (unsigned*)d_ws;
    auto take = [&](size_t bytes) { char* r = w + off; off = al256(off + bytes); return r; };
    p.ssq = (float*)take(((size_t)9 * TP * 16 + (size_t)9 * TS * 64) * 4);
    p.xres = (float*)take((size_t)T * D * 4);
    p.xres2 = (float*)take((size_t)T * D * 4);
    p.xb = (bf16_t*)take((size_t)T * D * 2);
    p.proj = (bf16_t*)take((size_t)T * NIN * 2);
    p.act = (bf16_t*)take((size_t)T * 4096 * 2);
    p.sm1 = (float*)take((size_t)T * 32 * 4);
    p.sm2 = (float*)take((size_t)T * 32 * 4);
    p.ymix = (float*)take((size_t)T * 2048 * 4);
    p.ab = (bf16_t*)take((size_t)T * 2048 * 2);
    p.u = (bf16_t*)take((size_t)T * DFF * 2);
    p.rope = (float*)take((size_t)(PL + SL) * 128 * 2 * 4);
    for (int l = 0; l < 4; ++l) {
        p.w_in[l] = (bf16_t*)take((size_t)NIN * D * 2);
        p.w_out[l] = (bf16_t*)take((size_t)D * 2048 * 2);
        p.w_up[l] = (bf16_t*)take((size_t)DFF * D * 2);
        p.w_dn[l] = (bf16_t*)take((size_t)D * DFF * 2);
    }
    p.gU = (bf16_t*)take((size_t)4096 * 64 * 128 * 2); p.gW = (bf16_t*)take((size_t)4096 * 64 * 128 * 2); p.gQd = (bf16_t*)take((size_t)4096 * 64 * 128 * 2);
    p.gKdT = (bf16_t*)take((size_t)4096 * 128 * 64 * 2); p.gAt = (bf16_t*)take((size_t)4096 * 64 * 64 * 2);
    hipMemsetAsync(d_ws, 0, 16384, stream);
    hipLaunchKernelGGL(mega_fwd, dim3(grid), dim3(NT), LDS_BYTES, stream, p);
}
```

```cpp
#include <hip/hip_runtime.h>
#include <stdint.h>

typedef uint16_t bf16_t;

#define REP_GEMM 1
#define REP_CHUNK 1
#define REP_SAMP 1
#define REP_ELEM 1
#define REP_P0 1
#define REP_BAR 1
#define REPEAT(n) _Pragma("unroll 1") for (int rep_ = 0; rep_ < (n); ++rep_)

constexpr int D = 1024;
constexpr int NPB = 8, PL = 2048, NSB = 128, SL = 4;
constexpr int TP = NPB * PL, TS = NSB * SL, T = TP + TS;
constexpr int NSEQ = NPB + NSB;
constexpr int PAST = 16384;
constexpr int NIN = 6400;
constexpr int DFF = 4096;
constexpr int NT = 512;
constexpr float EPS = 1e-6f;

constexpr size_t O_YP = 0;
constexpr size_t O_YS = O_YP + (size_t)TP * D;
constexpr size_t O_PRET = O_YS + (size_t)TS * D;
constexpr size_t RET_ST = (size_t)4 * 256 * 512;
constexpr size_t O_PSSD = O_PRET + 2 * NPB * RET_ST;
constexpr size_t SSD_ST = (size_t)32 * 64 * 128;
constexpr size_t O_PSSDC = O_PSSD + NPB * SSD_ST;
constexpr size_t CONV_ST = (size_t)3 * 4096;
constexpr size_t O_PGDN = O_PSSDC + NPB * CONV_ST;
constexpr size_t GDN_ST = (size_t)16 * 128 * 128;
constexpr size_t O_PGDNC = O_PGDN + NPB * GDN_ST;
constexpr size_t O_SRET = O_PGDNC + NPB * CONV_ST;
constexpr size_t O_SSSD = O_SRET + 2 * NSB * RET_ST;
constexpr size_t O_SSSDC = O_SSSD + NSB * SSD_ST;
constexpr size_t O_SGDN = O_SSSDC + NSB * CONV_ST;
constexpr size_t O_SGDNC = O_SGDN + NSB * GDN_ST;
constexpr size_t O_END = O_SGDNC + NSB * CONV_ST;

struct P {
    const float* in[28];
    float* out; unsigned* bar; float* ssq;
    float* xres; float* xres2; bf16_t* xb; bf16_t* proj; bf16_t* act; float* sm1; float* sm2; float* ymix; bf16_t* ab; bf16_t* u; float* rope;
    bf16_t* w_in[4]; bf16_t* w_out[4]; bf16_t* w_up[4]; bf16_t* w_dn[4];
    bf16_t* gU; bf16_t* gW; bf16_t* gQd; bf16_t* gKdT; bf16_t* gAt;
};

__device__ __forceinline__ float bf2f(bf16_t b) { return __uint_as_float(((uint32_t)b) << 16); }
__device__ __forceinline__ bf16_t f2bf(float f) { uint32_t r; asm("v_cvt_pk_bf16_f32 %0, %1, 0" : "=v"(r) : "v"(f)); return (bf16_t)r; }
__device__ __forceinline__ uint32_t pack_bf2(float a, float b) { uint32_t r; asm("v_cvt_pk_bf16_f32 %0, %1, %2" : "=v"(r) : "v"(a), "v"(b)); return r; }
typedef float nt_f4 __attribute__((ext_vector_type(4)));
typedef unsigned nt_u4 __attribute__((ext_vector_type(4)));
typedef unsigned nt_u2 __attribute__((ext_vector_type(2)));
__device__ __forceinline__ uint4 ld_nt_u4(const void* p) { const nt_u4 v = __builtin_nontemporal_load((const nt_u4*)p); return make_uint4(v[0], v[1], v[2], v[3]); }
__device__ __forceinline__ uint2 ld_nt_u2(const void* p) { const nt_u2 v = __builtin_nontemporal_load((const nt_u2*)p); return make_uint2(v[0], v[1]); }
__device__ __forceinline__ float4 ld_nt4(const float* p) { const nt_f4 v = __builtin_nontemporal_load((const nt_f4*)p); return make_float4(v[0], v[1], v[2], v[3]); }
__device__ __forceinline__ void st_nt4(float* p, float a, float b, float c, float d) { const nt_f4 t = {a, b, c, d}; __builtin_nontemporal_store(t, (nt_f4*)p); }
__device__ __forceinline__ float silu_f(float x) { return x * __builtin_amdgcn_rcpf(1.f + __expf(-x)); }
__device__ __forceinline__ float sigmoid_f(float x) { return __builtin_amdgcn_rcpf(1.f + __expf(-x)); }
__device__ __forceinline__ float softplus_f(float x) { const float e = __expf(-fabsf(x)); return fmaxf(x, 0.f) + ((e < 1e-3f) ? e * (1.f - 0.5f * e) : __logf(1.f + e)); }

__device__ __forceinline__ int xcd_unit(int u, int G) { return (G == 256) ? ((u & 7) * 32 + (u >> 3)) : u; }

__device__ __forceinline__ int opaque_tid() { int t = threadIdx.x; asm volatile("" : "+v"(t)); return t; }

__device__ __forceinline__ float row16_sum(float v) {
    v += __builtin_bit_cast(float, __builtin_amdgcn_update_dpp(0, __builtin_bit_cast(int, v), 0x128, 0xF, 0xF, false));
    v += __builtin_bit_cast(float, __builtin_amdgcn_update_dpp(0, __builtin_bit_cast(int, v), 0x124, 0xF, 0xF, false));
    v += __builtin_bit_cast(float, __builtin_amdgcn_update_dpp(0, __builtin_bit_cast(int, v), 0x122, 0xF, 0xF, false));
    v += __builtin_bit_cast(float, __builtin_amdgcn_update_dpp(0, __builtin_bit_cast(int, v), 0x121, 0xF, 0xF, false));
    return v;
}

__device__ __forceinline__ float wave_sum(float v) { v = row16_sum(v); v += __shfl_xor(v, 16); v += __shfl_xor(v, 32); return v; }
__device__ __forceinline__ float half_sum(float v) { v = row16_sum(v); v += __shfl_xor(v, 16); return v; }

__device__ __forceinline__ void seq_info(int s, int& tok0, int& L, int& pos_row0) {
    if (s < NPB) { tok0 = s * PL; L = PL; pos_row0 = 0; }
    else { tok0 = TP + (s - NPB) * SL; L = SL; pos_row0 = PL; }
}


#define XB_TMO      128
#define XB_XCNT(j)  (256  + 64 * (j))
#define XB_XSUB(j)  (1280 + 64 * (j))
#define XB_XGEN(j)  (2304 + 64 * (j))
#define XB_TOP      3328
#define XB_TOPGEN   3392
#define XCD_BAR_WORDS 3456
#define XB_SPIN_CAP (1u << 22)
#define LAS __attribute__((address_space(3)))

__device__ __forceinline__ unsigned xb_ld(unsigned* p)              { return __hip_atomic_load(p, __ATOMIC_RELAXED, __HIP_MEMORY_SCOPE_AGENT); }
__device__ __forceinline__ unsigned xb_add(unsigned* p, unsigned v) { return __hip_atomic_fetch_add(p, v, __ATOMIC_RELAXED, __HIP_MEMORY_SCOPE_AGENT); }
__device__ __forceinline__ unsigned xb_xcc_id() { return (unsigned)__builtin_amdgcn_s_getreg((3 << 11) | 20) & 0xFu; }
#define XB_SPIN(cond, bar) do { unsigned _sp = 0; while (cond) { __builtin_amdgcn_s_sleep(1); \
    if ((++_sp & 255u) == 0u) { if (xb_ld(&(bar)[XB_TMO])) break; if (_sp > XB_SPIN_CAP) { atomicAdd(&(bar)[XB_TMO], 1u); break; } } } } while (0)

struct XcdBarrier {
    unsigned* bar; unsigned x;
    volatile LAS unsigned* st;
};

__device__ __forceinline__ XcdBarrier xcd_barrier_post(unsigned* bar, volatile LAS unsigned* st) {
    XcdBarrier b; b.bar = bar; b.x = xb_xcc_id(); b.st = st;
    if (threadIdx.x == 0) (void)xb_add(&bar[XB_XCNT(b.x)], 1u);
    return b;
}
__device__ __forceinline__ void xcd_barrier_complete(unsigned* bar, unsigned x, unsigned& nloc, unsigned& nx) {
    const unsigned G = gridDim.x * gridDim.y * gridDim.z;
    unsigned sum, cnt, mine, sp = 0u;
    for (;;) {
        sum = 0u; cnt = 0u; mine = 0u;
#pragma unroll
        for (unsigned j = 0; j < 16; ++j) { const unsigned c = xb_ld(&bar[XB_XCNT(j)]); sum += c; cnt += (c > 0u) ? 1u : 0u; mine = (j == x) ? c : mine; }
        if (sum == G) break;
        __builtin_amdgcn_s_sleep(1);
        if ((++sp & 255u) == 0u) { if (xb_ld(&bar[XB_TMO])) break; if (sp > XB_SPIN_CAP) { atomicAdd(&bar[XB_TMO], 1u); break; } }
    }
    nloc = mine > 0u ? mine : 1u; nx = cnt > 0u ? cnt : 1u;
}

__device__ __forceinline__ void xcd_barrier(const XcdBarrier& b) {
    asm volatile("s_waitcnt vmcnt(0)" ::: "memory");
    __syncthreads();
    if (threadIdx.x == 0) {
        unsigned* bar = b.bar;
        __builtin_amdgcn_s_waitcnt(0);
        unsigned nloc = b.st[0], nx = b.st[1];
        if (nloc == 0u) { xcd_barrier_complete(bar, b.x, nloc, nx); b.st[0] = nloc; b.st[1] = nx; }
        const unsigned old = xb_add(&bar[XB_XSUB(b.x)], 1u);
        const unsigned gen = old / nloc;
        if (old + 1u == (gen + 1u) * nloc) {
            __builtin_amdgcn_fence(__ATOMIC_RELEASE, "agent");
            asm volatile("s_waitcnt vmcnt(0)" ::: "memory");
            const unsigned og = xb_add(&bar[XB_TOP], 1u);
            const unsigned tg = og / nx;
            if (og + 1u == (tg + 1u) * nx) xb_add(&bar[XB_TOPGEN], 1u);
            else XB_SPIN(xb_ld(&bar[XB_TOPGEN]) == tg, bar);
            __builtin_amdgcn_fence(__ATOMIC_ACQUIRE, "agent");
            xb_add(&bar[XB_XGEN(b.x)], 1u);
            asm volatile("s_waitcnt vmcnt(0)" ::: "memory");
        } else {
            XB_SPIN(xb_ld(&bar[XB_XGEN(b.x)]) == gen, bar);
            __builtin_amdgcn_fence(__ATOMIC_ACQUIRE, "agent");
            asm volatile("s_waitcnt vmcnt(0)" ::: "memory");
        }
    }
    __syncthreads();
}


namespace pg8 {
#define PG8_LAS __attribute__((address_space(3)))
typedef unsigned short bf16_t;
typedef short bf16x8 __attribute__((ext_vector_type(8)));
typedef float f32x4 __attribute__((ext_vector_type(4)));
typedef unsigned u32x4 __attribute__((ext_vector_type(4)));
typedef unsigned u32x2 __attribute__((ext_vector_type(2)));
constexpr int BM = 256, BK = 64, HALF = 128, HTB = HALF * BK * 2  , STAGE_BYTES = 8 * HTB, NXCD = 8, WGM = 8;

__host__ __device__ __forceinline__ int lds_byte(int r, int c) { const int st = (r >> 4) * 2 + (c >> 5), rr = r & 15, cc = c & 31, ob = rr * 64 + cc * 2; return st * 1024 + (ob ^ (((ob >> 9) & 1) << 5)); }
__host__ __device__ __forceinline__ void stage_rc(int b, int& R, int& C) { const int st = b / 1024, sb = b % 1024, swz = sb ^ (((sb >> 9) & 1) << 5); R = (st >> 1) * 16 + swz / 64; C = (st & 1) * 32 + (swz % 64) / 2; }
__host__ __device__ __forceinline__ int perm32(int rho) { const int n = rho >> 4, i = rho & 15; return 8 * (i >> 2) + 4 * n + (i & 3); }

struct Unit { int pm, pn; };
struct Gemm { const bf16_t* A; const bf16_t* Bt; int M, N, K; };

struct StaticOrder {
    int nM, nN, nwg, G, c;
    __host__ __device__ void init(int M, int N, int G_, int c_) { nM = M / BM; nN = N / BM; nwg = nM * nN; G = G_; c = c_; }
    __host__ __device__ bool next(int i, Unit& u) const {
        const long L = (long)i * G + c; if (L >= nwg) return false;
        int wgid = (int)L; { const int q = nwg / NXCD, r = nwg % NXCD, xcd = wgid % NXCD, off = wgid / NXCD; wgid = (xcd < r ? xcd * (q + 1) : r * (q + 1) + (xcd - r) * q) + off; }
        const int nig = WGM * nN, gid = wgid / nig, fm = gid * WGM, gsz = (nM - fm) < WGM ? (nM - fm) : WGM;
        u.pm = fm + ((wgid % nig) % gsz); u.pn = (wgid % nig) / gsz; return true;
    }
    __device__ __forceinline__ void a_ready(const Unit&) const {}
    __device__ __forceinline__ void done(const Unit&) const {}
};
__device__ __forceinline__ unsigned cvt_pk_bf16(float lo, float hi) { unsigned r; asm volatile("v_cvt_pk_bf16_f32 %0, %1, %2" : "=v"(r) : "v"(lo), "v"(hi)); return r; }
typedef float f32x2 __attribute__((ext_vector_type(2)));
__device__ __forceinline__ f32x2 gelu_pk(f32x2 v) {
    const f32x2 av = __builtin_elementwise_abs(v), d = av * 0.2316418882f + 1.0f;
    f32x2 t; t.x = __builtin_amdgcn_rcpf(d.x); t.y = __builtin_amdgcn_rcpf(d.y);
    f32x2 q = t * 0.5307027145f + (-0.7265760135f); q = q * t + 0.7107068705f; q = q * t + (-0.142248368f); q = q * t + 0.127414796f; q = q * t;
    const f32x2 s = (v * v) * (-0.72134752044f);
    f32x2 e; e.x = __builtin_amdgcn_exp2f(s.x); e.y = __builtin_amdgcn_exp2f(s.y);
    const f32x2 m = v * (q * e), r = v - m;
    f32x2 o; o.x = v.x < 0.f ? m.x : r.x; o.y = v.y < 0.f ? m.y : r.y; return o;
}

struct EpiF32 {
    static constexpr bool PERM = false, AFTER_DRAIN = false, ACC_INIT = false;
    float* C; int ldc; const float* bias;
    __device__ __forceinline__ void operator()(const f32x4 (&acc)[2][2][4][2], const Unit& u, int wr, int wc, int fr, int fq) const {
        const int row0 = u.pm * BM + wr * 64 + fr, col0 = u.pn * BM + wc * 32 + 4 * fq;
        f32x4 bv[2][2];
#pragma unroll
        for (int bj = 0; bj < 2; ++bj)
#pragma unroll
            for (int n = 0; n < 2; ++n) bv[bj][n] = bias ? *(const f32x4*)(bias + col0 + bj * HALF + n * 16) : (f32x4){0.f, 0.f, 0.f, 0.f};
#pragma unroll
        for (int ai = 0; ai < 2; ++ai)
#pragma unroll
            for (int m = 0; m < 4; ++m) { float* rowp = C + (size_t)(row0 + ai * HALF + m * 16) * ldc + col0;
#pragma unroll
                for (int bj = 0; bj < 2; ++bj)
#pragma unroll
                    for (int n = 0; n < 2; ++n) *(f32x4*)(rowp + bj * HALF + n * 16) = acc[ai][bj][m][n] + bv[bj][n]; }
    }
};
template <int ACT  > struct EpiBf16 {
    static constexpr bool PERM = true, AFTER_DRAIN = false, ACC_INIT = false;
    bf16_t* O; int ldc; const float* bias; int split_cols; size_t split_stride;
    __device__ __forceinline__ void operator()(const f32x4 (&acc)[2][2][4][2], const Unit& u, int wr, int wc, int fr, int fq) const {
        const int row0 = u.pm * BM + wr * 64 + fr; int colt = u.pn * BM; bf16_t* base = O;
        if (split_cols) { const int t = colt / split_cols; base += (size_t)t * split_stride; colt -= t * split_cols; }
        const int col0 = colt + wc * 32 + 8 * fq, bcol0 = u.pn * BM + wc * 32 + 8 * fq;
        f32x4 bv[2][2];
#pragma unroll
        for (int bj = 0; bj < 2; ++bj)
#pragma unroll
            for (int n = 0; n < 2; ++n) bv[bj][n] = bias ? *(const f32x4*)(bias + bcol0 + bj * HALF + 4 * n) : (f32x4){0.f, 0.f, 0.f, 0.f};
#pragma unroll
        for (int ai = 0; ai < 2; ++ai)
#pragma unroll
            for (int m = 0; m < 4; ++m) { bf16_t* rowp = base + (size_t)(row0 + ai * HALF + m * 16) * ldc + col0;
#pragma unroll
                for (int bj = 0; bj < 2; ++bj) { f32x4 v0 = acc[ai][bj][m][0] + bv[bj][0], v1 = acc[ai][bj][m][1] + bv[bj][1];
                    if (ACT == 1) { f32x2 a = gelu_pk((f32x2){v0[0], v0[1]}), b = gelu_pk((f32x2){v0[2], v0[3]}), c = gelu_pk((f32x2){v1[0], v1[1]}), d = gelu_pk((f32x2){v1[2], v1[3]});
                        v0 = (f32x4){a.x, a.y, b.x, b.y}; v1 = (f32x4){c.x, c.y, d.x, d.y}; }
                    if (ACT == 2) {
#pragma unroll
                        for (int j = 0; j < 4; ++j) { v0[j] = 0.5f * v0[j] * (1.0f + erff(v0[j] * 0.70710678f)); v1[j] = 0.5f * v1[j] * (1.0f + erff(v1[j] * 0.70710678f)); } }
                    u32x4 w; w.x = cvt_pk_bf16(v0[0], v0[1]); w.y = cvt_pk_bf16(v0[2], v0[3]); w.z = cvt_pk_bf16(v1[0], v1[1]); w.w = cvt_pk_bf16(v1[2], v1[3]);
                    *(u32x4*)(rowp + bj * HALF) = w; } }
    }
};

template <class Epi, class Sched, bool STAMP = false>
__device__ __forceinline__ void gemm_phase(PG8_LAS unsigned char* lds, const Gemm g, const Sched& S, const Epi& E, unsigned long long* stamps) {
    const int tid = ::opaque_tid(), wid = __builtin_amdgcn_readfirstlane(tid >> 6), lane = tid & 63, wr = wid >> 2, wc = wid & 3, fr = lane & 15, fq = lane >> 4;
    const int K = g.K, nt = K / BK;
    int ts_lo = 0, ts_hi = 0, nts = 0; const unsigned long long rt_entry = STAMP ? (unsigned long long)wall_clock64() : 0ull;
#define PG8_STAMP() do { if (STAMP && wid == 0 && nts < 64) { const unsigned long long _c = (unsigned long long)clock64(); \
        ts_lo = (lane == nts) ? (int)(unsigned)_c : ts_lo; ts_hi = (lane == nts) ? (int)(unsigned)(_c >> 32) : ts_hi; ++nts; } } while (0)
    PG8_STAMP();
    unsigned voffA[2], voffB[2];
#pragma unroll
    for (int i = 0; i < 2; ++i) { int R, C; stage_rc(tid * 16 + i * 8192, R, C); const int Rb = Epi::PERM ? ((R & ~31) + perm32(R & 31)) : R;
        voffA[i] = (unsigned)(R * K + C) * 2u; voffB[i] = (unsigned)(Rb * K + C) * 2u; }
    const size_t kstep = (size_t)(BK * 2);
    const size_t hstep = (size_t)HALF * K * 2;
    const size_t tstep = 2 * hstep;
    const unsigned ldsw = (unsigned)wid * 1024u;
    const int aoff = lds_byte(wr * 64 + fr, fq * 8), boff = lds_byte(wc * 32 + fr, fq * 8);
#define PG8_SA(b, h) (((b) * 2 + (h)) * HTB)
#define PG8_SB(b, h) ((4 + (b) * 2 + (h)) * HTB)
#define PG8_STAGE(bufoff, gbase, voff) do { _Pragma("unroll") for (int _i = 0; _i < 2; ++_i) \
        __builtin_amdgcn_global_load_lds((const unsigned*)((const char*)(gbase) + (voff)[_i]), (PG8_LAS unsigned*)(lds + (bufoff) + ldsw + _i * 8192), 16, 0, 0); } while (0)
#define PG8_LDA(dst, b, h) do { _Pragma("unroll") for (int m = 0; m < 4; ++m) _Pragma("unroll") for (int k = 0; k < 2; ++k) dst[m][k] = *(const PG8_LAS bf16x8*)(lds + PG8_SA(b, h) + aoff + m * 2048 + k * 1024); } while (0)
#define PG8_LDB(dst, b, h) do { _Pragma("unroll") for (int n = 0; n < 2; ++n) _Pragma("unroll") for (int k = 0; k < 2; ++k) dst[n][k] = *(const PG8_LAS bf16x8*)(lds + PG8_SB(b, h) + boff + n * 2048 + k * 1024); } while (0)
#define PG8_MMA(ai, bj, At, Bt) do { __builtin_amdgcn_s_setprio(1); _Pragma("unroll") for (int m = 0; m < 4; ++m) _Pragma("unroll") for (int n = 0; n < 2; ++n) _Pragma("unroll") for (int k = 0; k < 2; ++k) \
        acc[ai][bj][m][n] = __builtin_amdgcn_mfma_f32_16x16x32_bf16(Bt[n][k], At[m][k], acc[ai][bj][m][n], 0, 0, 0); __builtin_amdgcn_s_setprio(0); } while (0)
#define PG8_WAIT_V(n) asm volatile("s_waitcnt vmcnt(" #n ")" ::: "memory")
#define PG8_WAIT_L(n) asm volatile("s_waitcnt lgkmcnt(" #n ")" ::: "memory")
#define PG8_BAR __builtin_amdgcn_s_barrier()
#define PG8_SCHED __builtin_amdgcn_sched_barrier(0)
    Unit cur, nxt; int ui = 0;
    if (!S.next(0, cur)) return;
    f32x4 acc[2][2][4][2];
    if constexpr (Epi::ACC_INIT) E.init(acc, cur, wr, wc, fr, fq);
    else {
#pragma unroll
    for (int a = 0; a < 2; ++a)
#pragma unroll
        for (int b = 0; b < 2; ++b)
#pragma unroll
            for (int m = 0; m < 4; ++m)
#pragma unroll
                for (int n = 0; n < 2; ++n) acc[a][b][m][n] = (f32x4){0.f, 0.f, 0.f, 0.f};
    }
    bf16x8 At[4][2], B0[2][2], B1[2][2];
    const char* cA = (const char*)g.A + (size_t)cur.pm * tstep; const char* cB = (const char*)g.Bt + (size_t)cur.pn * tstep;
    S.a_ready(cur);
    PG8_STAGE(PG8_SB(0, 0), cB, voffB); PG8_STAGE(PG8_SA(0, 0), cA, voffA); PG8_STAGE(PG8_SB(0, 1), cB + hstep, voffB); PG8_STAGE(PG8_SA(0, 1), cA + hstep, voffA);
    if (wr == 1) PG8_BAR;
    PG8_WAIT_V(4); PG8_BAR;
    PG8_STAGE(PG8_SB(1, 0), cB + kstep, voffB); PG8_STAGE(PG8_SA(1, 0), cA + kstep, voffA); PG8_STAGE(PG8_SB(1, 1), cB + hstep + kstep, voffB);
    PG8_WAIT_V(6); PG8_BAR;
    PG8_STAMP();
    for (;;) {
        const bool has_next = S.next(ui + 1, nxt);
        const char* nA = has_next ? (const char*)g.A + (size_t)nxt.pm * tstep : cA; const char* nB = has_next ? (const char*)g.Bt + (size_t)nxt.pn * tstep : cB;
        for (int t = 0; t < nt; t += 2) {
            const bool last = (t == nt - 2);
            const char* a1 = cA + (size_t)(t + 1) * kstep;
            const char* a2 = last ? nA : cA + (size_t)(t + 2) * kstep; const char* b2 = last ? nB : cB + (size_t)(t + 2) * kstep;
            const char* a3 = a2 + kstep; const char* b3 = b2 + kstep;
            if (last && has_next) S.a_ready(nxt);
            PG8_LDB(B0, 0, 0); PG8_SCHED; PG8_LDA(At, 0, 0); PG8_STAGE(PG8_SA(1, 1), a1 + hstep, voffA);
            PG8_WAIT_L(8); PG8_BAR; PG8_WAIT_L(0); PG8_MMA(0, 0, At, B0); PG8_BAR; PG8_SCHED;
            PG8_LDB(B1, 0, 1); PG8_STAGE(PG8_SB(0, 0), b2, voffB);
            PG8_BAR; PG8_WAIT_L(0); PG8_MMA(0, 1, At, B1); PG8_BAR;
            PG8_LDA(At, 0, 1); PG8_STAGE(PG8_SA(0, 0), a2, voffA);
            PG8_BAR; PG8_WAIT_L(0); PG8_MMA(1, 0, At, B0); PG8_BAR; PG8_SCHED;
            PG8_STAGE(PG8_SB(0, 1), b2 + hstep, voffB);
            PG8_WAIT_V(6); PG8_BAR; PG8_MMA(1, 1, At, B1); PG8_BAR;
            PG8_LDB(B0, 1, 0); PG8_SCHED; PG8_LDA(At, 1, 0); PG8_STAGE(PG8_SA(0, 1), a2 + hstep, voffA);
            PG8_WAIT_L(8); PG8_BAR; PG8_WAIT_L(0); PG8_MMA(0, 0, At, B0); PG8_BAR; PG8_SCHED;
            PG8_LDB(B1, 1, 1); PG8_STAGE(PG8_SB(1, 0), b3, voffB);
            PG8_BAR; PG8_WAIT_L(0); PG8_MMA(0, 1, At, B1); PG8_BAR;
            PG8_LDA(At, 1, 1); PG8_STAGE(PG8_SA(1, 0), a3, voffA);
            PG8_BAR; PG8_WAIT_L(0); PG8_MMA(1, 0, At, B0); PG8_BAR; PG8_SCHED;
            PG8_STAGE(PG8_SB(1, 1), b3 + hstep, voffB);
            PG8_WAIT_V(6); PG8_BAR; PG8_MMA(1, 1, At, B1); PG8_BAR;
        }
        PG8_STAMP();
        if constexpr (!Epi::AFTER_DRAIN) { E(acc, cur, wr, wc, fr, fq); S.done(cur); }
        PG8_STAMP();
        if (!has_next) break;
        if constexpr (Epi::ACC_INIT) E.init(acc, nxt, wr, wc, fr, fq);
        else {
#pragma unroll
        for (int a = 0; a < 2; ++a)
#pragma unroll
            for (int b = 0; b < 2; ++b)
#pragma unroll
                for (int m = 0; m < 4; ++m)
#pragma unroll
                    for (int n = 0; n < 2; ++n) acc[a][b][m][n] = (f32x4){0.f, 0.f, 0.f, 0.f};
        }
        cur = nxt; cA = nA; cB = nB; ++ui;
    }
    PG8_WAIT_V(0);
    if (wr == 0) PG8_BAR;
    PG8_BAR;
    if constexpr (Epi::AFTER_DRAIN) { E.fused(acc, cur, wr, wc, fr, fq, lds, wid, lane); S.done(cur); }
    PG8_STAMP();
    if (STAMP && wid == 0) { stamps[lane] = lane < nts ? (((unsigned long long)(unsigned)ts_hi << 32) | (unsigned)ts_lo) : 0ull;
        if (lane == 62) stamps[62] = rt_entry; if (lane == 63) stamps[63] = (unsigned long long)wall_clock64(); }
#undef PG8_STAMP
#undef PG8_SA
#undef PG8_SB
#undef PG8_STAGE
#undef PG8_LDA
#undef PG8_LDB
#undef PG8_MMA
#undef PG8_WAIT_V
#undef PG8_WAIT_L
#undef PG8_BAR
#undef PG8_SCHED
}
}

namespace pg8 {
struct SsqRef { float* p16; float* p64; };
__device__ __forceinline__ float row_rs(const SsqRef q, int row) {
    float s = 0.f;
    if (row < 16384) { const f32x4* p = (const f32x4*)(q.p16 + (size_t)row * 16);
#pragma unroll
        for (int i = 0; i < 4; ++i) { const f32x4 v = p[i]; s += (v[0] + v[1]) + (v[2] + v[3]); }
    } else { const f32x4* p = (const f32x4*)(q.p64 + (size_t)(row - 16384) * 64);
#pragma unroll
        for (int i = 0; i < 16; ++i) { const f32x4 v = p[i]; s += (v[0] + v[1]) + (v[2] + v[3]); }
    }
    return rsqrtf(s * (1.f / 1024.f) + 1e-6f);
}
template <class Sched>
__device__ __forceinline__ void rs_table_build(PG8_LAS unsigned char* rst, const Sched& S, const SsqRef q, int tid) {
    PG8_LAS int* lst = (PG8_LAS int*)rst; PG8_LAS float* tab = (PG8_LAS float*)(rst + 32);
    int n = 0; Unit u;
    int seen[8];
#pragma unroll
    for (int k = 0; k < 8; ++k) seen[k] = -1;
#pragma unroll 1
    for (int i = 0; S.next(i, u); ++i) {
        bool dup = false;
#pragma unroll
        for (int k = 0; k < 8; ++k) dup |= (seen[k] == u.pm);
        if (dup || n >= 8) continue;
#pragma unroll
        for (int k = 0; k < 8; ++k) if (k == n) seen[k] = u.pm;
        ++n;
    }
#pragma unroll
    for (int k = 0; k < 4; ++k) {
        const int idx = tid + 512 * k, slot = idx >> 8, r = idx & 255;
        int pm = -1;
#pragma unroll
        for (int j = 0; j < 8; ++j) pm = (j == slot) ? seen[j] : pm;
        if (slot < n) tab[idx] = row_rs(q, pm * BM + r);
    }
    if (tid < 8) {
        int v = -1;
#pragma unroll
        for (int k = 0; k < 8; ++k) v = (k == tid) ? seen[k] : v;
        lst[tid] = v;
    }
    __syncthreads();
}
__device__ __forceinline__ const PG8_LAS float* rs_table_find(PG8_LAS const unsigned char* rst, int pm) {
    const PG8_LAS int* lst = (const PG8_LAS int*)rst; int k = 0;
#pragma unroll
    for (int i = 1; i < 8; ++i) k = (lst[i] == pm) ? i : k;
    return (const PG8_LAS float*)(rst + 32) + k * 256;
}
struct EpiProjS {
    static constexpr bool PERM = true, AFTER_DRAIN = false, ACC_INIT = false;
    bf16_t* O; int ldc; PG8_LAS const unsigned char* rst;
    __device__ __forceinline__ void operator()(const f32x4 (&acc)[2][2][4][2], const Unit& u, int wr, int wc, int fr, int fq) const {
        const int row0 = u.pm * BM + wr * 64 + fr, col0 = u.pn * BM + wc * 32 + 8 * fq;
        const PG8_LAS float* rsl = rs_table_find(rst, u.pm);
#pragma unroll
        for (int ai = 0; ai < 2; ++ai)
#pragma unroll
            for (int m = 0; m < 4; ++m) { const int row = row0 + ai * HALF + m * 16; const float rs = rsl[wr * 64 + fr + ai * HALF + m * 16]; bf16_t* rowp = O + (size_t)row * ldc + col0;
#pragma unroll
                for (int bj = 0; bj < 2; ++bj) { const f32x4 v0 = acc[ai][bj][m][0] * rs, v1 = acc[ai][bj][m][1] * rs;
                    u32x4 w; w.x = cvt_pk_bf16(v0[0], v0[1]); w.y = cvt_pk_bf16(v0[2], v0[3]); w.z = cvt_pk_bf16(v1[0], v1[1]); w.w = cvt_pk_bf16(v1[2], v1[3]);
                    *(u32x4*)(rowp + bj * HALF) = w; } }
    }
};
struct EpiSqrelu {
    static constexpr bool PERM = true, AFTER_DRAIN = false, ACC_INIT = false;
    bf16_t* O; int ldc; PG8_LAS const unsigned char* rst;
    __device__ __forceinline__ void operator()(const f32x4 (&acc)[2][2][4][2], const Unit& u, int wr, int wc, int fr, int fq) const {
        const int row0 = u.pm * BM + wr * 64 + fr, col0 = u.pn * BM + wc * 32 + 8 * fq;
        const PG8_LAS float* rsl = rs_table_find(rst, u.pm);
#pragma unroll
        for (int ai = 0; ai < 2; ++ai)
#pragma unroll
            for (int m = 0; m < 4; ++m) { const int row = row0 + ai * HALF + m * 16; const float rs = rsl[wr * 64 + fr + ai * HALF + m * 16]; bf16_t* rowp = O + (size_t)row * ldc + col0;
#pragma unroll
                for (int bj = 0; bj < 2; ++bj) { f32x4 v0 = acc[ai][bj][m][0], v1 = acc[ai][bj][m][1];
#pragma unroll
                    for (int j = 0; j < 4; ++j) { const float a = fmaxf(v0[j], 0.f) * rs, b = fmaxf(v1[j], 0.f) * rs; v0[j] = a * a; v1[j] = b * b; }
                    u32x4 w; w.x = cvt_pk_bf16(v0[0], v0[1]); w.y = cvt_pk_bf16(v0[2], v0[3]); w.z = cvt_pk_bf16(v1[0], v1[1]); w.w = cvt_pk_bf16(v1[2], v1[3]);
                    *(u32x4*)(rowp + bj * HALF) = w; } }
    }
};
struct EpiResN {
    static constexpr bool PERM = false, AFTER_DRAIN = false, ACC_INIT = true;
    const float* base; float* out; int ldc; bf16_t* xb; float* ssq16;
    __device__ __forceinline__ void init(f32x4 (&acc)[2][2][4][2], const Unit& u, int wr, int wc, int fr, int fq) const {
        const int row0 = u.pm * BM + wr * 64 + fr, col0 = u.pn * BM + wc * 32 + 4 * fq;
#pragma unroll
        for (int ai = 0; ai < 2; ++ai)
#pragma unroll
            for (int m = 0; m < 4; ++m)
#pragma unroll
                for (int bj = 0; bj < 2; ++bj)
#pragma unroll
                    for (int n = 0; n < 2; ++n) acc[ai][bj][m][n] = __builtin_nontemporal_load((const f32x4*)(base + (size_t)(row0 + ai * HALF + m * 16) * ldc + col0 + bj * HALF + n * 16));
    }
    __device__ __forceinline__ void operator()(const f32x4 (&acc)[2][2][4][2], const Unit& u, int wr, int wc, int fr, int fq) const {
        const int row0 = u.pm * BM + wr * 64 + fr, col0 = u.pn * BM + wc * 32 + 4 * fq;
#pragma unroll
        for (int ai = 0; ai < 2; ++ai)
#pragma unroll
            for (int m = 0; m < 4; ++m) { const int row = row0 + ai * HALF + m * 16; const size_t off = (size_t)row * ldc + col0; float ss = 0.f;
#pragma unroll
                for (int bj = 0; bj < 2; ++bj)
#pragma unroll
                    for (int n = 0; n < 2; ++n) { const f32x4 o = acc[ai][bj][m][n]; __builtin_nontemporal_store(o, (f32x4*)(out + off + bj * HALF + n * 16));
                        ss += (o[0] * o[0] + o[1] * o[1]) + (o[2] * o[2] + o[3] * o[3]);
                        u32x2 w; w.x = cvt_pk_bf16(o[0], o[1]); w.y = cvt_pk_bf16(o[2], o[3]); *(u32x2*)(xb + off + bj * HALF + n * 16) = w; }
                ss += __shfl_xor(ss, 16); ss += __shfl_xor(ss, 32);
                if (fq == 0) ssq16[(size_t)row * 16 + u.pn * 4 + wc] = ss; }
    }
};
}

__device__ __forceinline__ void k_prep_w(unsigned char* lds, const int bid, const int G, const float* __restrict__ W, bf16_t* __restrict__ Wt, int K, int N, int Npad, const float* __restrict__ scale, int period) {
    const int tid = opaque_tid();
    const int total = Npad * (K >> 3);
    for (int i = bid * NT + tid; i < total; i += 2 * G * NT) {
        float v[2][8]; int n[2], kg[2]; bool ok[2];
#pragma unroll
        for (int u = 0; u < 2; ++u) {
            const int ii = i + u * G * NT; ok[u] = ii < total; const int i2 = ok[u] ? ii : i;
            kg[u] = i2 / Npad; n[u] = i2 - kg[u] * Npad;
#pragma unroll
            for (int j = 0; j < 8; ++j) v[u][j] = (n[u] < N) ? __builtin_nontemporal_load(W + (size_t)(kg[u] * 8 + j) * N + n[u]) : 0.f;
        }
#pragma unroll
        for (int u = 0; u < 2; ++u) {
            if (scale) {
#pragma unroll
                for (int j = 0; j < 8; ++j) v[u][j] *= scale[(kg[u] * 8 + j) % period];
            }
            uint4 pk; pk.x = pack_bf2(v[u][0], v[u][1]); pk.y = pack_bf2(v[u][2], v[u][3]); pk.z = pack_bf2(v[u][4], v[u][5]); pk.w = pack_bf2(v[u][6], v[u][7]);
            if (ok[u]) *(uint4*)(Wt + (size_t)n[u] * K + kg[u] * 8) = pk;
        }
    }
}

__device__ __forceinline__ void sincos_d(double x, double& s, double& c) {
    const double q = rint(x * 0.63661977236758134308);
    double r = fma(-q, 1.57079632679489655800e+00, x);
    r = fma(-q, 6.12323399573676603587e-17, r);
    const double r2 = r * r;
    double sp = -7.6471637318198164759e-13; sp = fma(sp, r2, 1.6059043836821614599e-10); sp = fma(sp, r2, -2.5052108385441718775e-08);
    sp = fma(sp, r2, 2.7557319223985890653e-06); sp = fma(sp, r2, -1.9841269841269841270e-04); sp = fma(sp, r2, 8.3333333333333333333e-03);
    sp = fma(sp, r2, -1.6666666666666666667e-01); const double sn = fma(sp * r2, r, r);
    double cp = 4.7794773323873852974e-14; cp = fma(cp, r2, -1.1470745597729724714e-11); cp = fma(cp, r2, 2.0876756987868098979e-09);
    cp = fma(cp, r2, -2.7557319223985890653e-07); cp = fma(cp, r2, 2.4801587301587301587e-05); cp = fma(cp, r2, -1.3888888888888888889e-03);
    cp = fma(cp, r2, 4.1666666666666666667e-02); cp = fma(cp, r2, -0.5); const double cs = fma(cp, r2, 1.0);
    const int qi = ((int)q) & 3;
    s = (qi == 0) ? sn : (qi == 1) ? cs : (qi == 2) ? -sn : -cs;
    c = (qi == 0) ? cs : (qi == 1) ? -sn : (qi == 2) ? -cs : sn;
}
__device__ __forceinline__ void k_rope(unsigned char* lds, const int bid, const int G, float* __restrict__ rope) {
    const int tid = opaque_tid();
    for (int idx = bid * NT + tid; idx < (PL + SL) * 128; idx += G * NT) {
    const int p = idx >> 7, i = idx & 127;
    const double pos = (p < PL) ? (double)p : (double)(PAST + p - PL);
    double inv = 1.0, b = 0.93057204092969897; int e = i;
    while (e) { if (e & 1) inv *= b; b *= b; e >>= 1; }
    double s, c; sincos_d(pos * inv, s, c);
    rope[(size_t)idx * 2] = (float)c; rope[(size_t)idx * 2 + 1] = (float)s;
    }
}

__device__ __forceinline__ void unpack_bf8(const uint4 r, float (&f)[8]) {
    f[0] = __uint_as_float(r.x << 16); f[1] = __uint_as_float(r.x & 0xffff0000u); f[2] = __uint_as_float(r.y << 16); f[3] = __uint_as_float(r.y & 0xffff0000u);
    f[4] = __uint_as_float(r.z << 16); f[5] = __uint_as_float(r.z & 0xffff0000u); f[6] = __uint_as_float(r.w << 16); f[7] = __uint_as_float(r.w & 0xffff0000u);
}
__device__ __forceinline__ void unpack_bf4(const uint2 r, float (&f)[4]) {
    f[0] = __uint_as_float(r.x << 16); f[1] = __uint_as_float(r.x & 0xffff0000u); f[2] = __uint_as_float(r.y << 16); f[3] = __uint_as_float(r.y & 0xffff0000u);
}

__device__ __forceinline__ void k_x_prep(unsigned char* lds, const int bid, const int G, const float* __restrict__ xp, const float* __restrict__ xs, float* __restrict__ xres, bf16_t* __restrict__ xb, const pg8::SsqRef ssq) {
    const int tid = opaque_tid(), lane = tid & 63, w = tid >> 6;
    for (int row = bid * 8 + w; row < T; row += G * 8) {
        const float4* xr = (const float4*)((row < TP) ? xp + (size_t)row * D : xs + (size_t)(row - TP) * D);
        float4 v[4]; float ss = 0.f;
#pragma unroll
        for (int i = 0; i < 4; ++i) { v[i] = ld_nt4((const float*)(xr + lane + 64 * i)); ss += v[i].x * v[i].x + v[i].y * v[i].y + v[i].z * v[i].z + v[i].w * v[i].w; }
        ss = wave_sum(ss);
        if (row < TP) { if (lane < 4) *(float4*)(ssq.p16 + (size_t)row * 16 + lane * 4) = make_float4(lane == 0 ? ss : 0.f, 0.f, 0.f, 0.f); }
        else if (lane < 16) *(float4*)(ssq.p64 + (size_t)(row - TP) * 64 + lane * 4) = make_float4(lane == 0 ? ss : 0.f, 0.f, 0.f, 0.f);
        float4* o = (float4*)(xres + (size_t)row * D); uint2* ob = (uint2*)(xb + (size_t)row * D);
#pragma unroll
        for (int i = 0; i < 4; ++i) { o[lane + 64 * i] = v[i]; uint2 pk; pk.x = pack_bf2(v[i].x, v[i].y); pk.y = pack_bf2(v[i].z, v[i].w); ob[lane + 64 * i] = pk; }
    }
}

__device__ __forceinline__ void k_final_norm(unsigned char* lds, const int bid, const int G, const float* __restrict__ xres, const pg8::SsqRef ssq, const float* __restrict__ wgt, float* __restrict__ out) {
    const int tid = opaque_tid(), lane = tid & 63, w = tid >> 6;
    for (int row = bid * 8 + w; row < T; row += G * 8) {
        const float4* xr = (const float4*)(xres + (size_t)row * D);
        const float rs = pg8::row_rs(ssq, row);
        float4* o = (float4*)(out + (size_t)row * D);
#pragma unroll
        for (int i = 0; i < 4; ++i) { const float4 v = ld_nt4((const float*)(xr + lane + 64 * i)); const float4 g = ((const float4*)wgt)[lane + 64 * i]; float4 r; r.x = v.x * rs * g.x; r.y = v.y * rs * g.y; r.z = v.z * rs * g.z; r.w = v.w * rs * g.w; st_nt4((float*)(o + lane + 64 * i), r.x, r.y, r.z, r.w); }
    }
}

template <int KIND>
__device__ __forceinline__ void gate_row_finish(float4 (&y)[8], const uint2 (&gp)[8], uint2* __restrict__ o, int lane) {
    float ssq[8];
#pragma unroll
    for (int i = 0; i < 8; ++i) {
        if (KIND == 1) { float g[4]; unpack_bf4(gp[i], g); y[i].x *= silu_f(g[0]); y[i].y *= silu_f(g[1]); y[i].z *= silu_f(g[2]); y[i].w *= silu_f(g[3]); }
        ssq[i] = (y[i].x * y[i].x + y[i].y * y[i].y) + (y[i].z * y[i].z + y[i].w * y[i].w);
    }
    float rs[8];
    if (KIND == 0) {
#pragma unroll
        for (int h = 0; h < 4; ++h) { const float r = rsqrtf(wave_sum(ssq[2 * h] + ssq[2 * h + 1]) * (1.f / 512.f) + EPS); rs[2 * h] = r; rs[2 * h + 1] = r; }
    } else if (KIND == 1) {
#pragma unroll
        for (int i = 0; i < 8; ++i) rs[i] = rsqrtf(wave_sum(ssq[i]) * (1.f / 256.f) + EPS);
    } else {
#pragma unroll
        for (int i = 0; i < 8; ++i) rs[i] = rsqrtf(half_sum(ssq[i]) * (1.f / 128.f) + EPS);
    }
#pragma unroll
    for (int i = 0; i < 8; ++i) {
        float r[4] = { y[i].x * rs[i], y[i].y * rs[i], y[i].z * rs[i], y[i].w * rs[i] };
        if (KIND != 1) { float g[4]; unpack_bf4(gp[i], g);
#pragma unroll
            for (int j = 0; j < 4; ++j) r[j] *= silu_f(g[j]); }
        uint2 pk; pk.x = pack_bf2(r[0], r[1]); pk.y = pack_bf2(r[2], r[3]); o[lane + 64 * i] = pk;
    }
}
template <int KIND>
__device__ __forceinline__ void k_gate(unsigned char* lds, const int bid, const int G, const float* __restrict__ ymix, const bf16_t* __restrict__ proj, bf16_t* __restrict__ ab) {
    const int tid = opaque_tid(), lane = tid & 63, w = tid >> 6;
    const int gcol0 = (KIND == 1) ? 0 : 4096;
    for (int row = bid * 8 + w; row < T; row += 2 * G * 8) {
        const int row2 = row + G * 8; const bool has2 = row2 < T; const int r2 = has2 ? row2 : row;
        const float4* yr = (const float4*)(ymix + (size_t)row * 2048); const float4* yr2 = (const float4*)(ymix + (size_t)r2 * 2048);
        const uint2* gr = (const uint2*)(proj + (size_t)row * NIN + gcol0); const uint2* gr2 = (const uint2*)(proj + (size_t)r2 * NIN + gcol0);
        float4 y[8], y2[8]; uint2 gp[8], gp2[8];
#pragma unroll
        for (int i = 0; i < 8; ++i) { y[i] = ld_nt4((const float*)(yr + lane + 64 * i)); gp[i] = ld_nt_u2(gr + lane + 64 * i); }
#pragma unroll
        for (int i = 0; i < 8; ++i) { y2[i] = ld_nt4((const float*)(yr2 + lane + 64 * i)); gp2[i] = ld_nt_u2(gr2 + lane + 64 * i); }
        gate_row_finish<KIND>(y, gp, (uint2*)(ab + (size_t)row * 2048), lane);
        if (has2) gate_row_finish<KIND>(y2, gp2, (uint2*)(ab + (size_t)row2 * 2048), lane);
    }
}

template <int MODE>
__device__ __forceinline__ void k_conv_pre(unsigned char* lds, const int bid, const int G, const bf16_t* __restrict__ proj, const float* __restrict__ cstate, const float* __restrict__ cw, const float* __restrict__ cb,
                                           const float* __restrict__ dt_bias, const float* __restrict__ a_log,
                                           bf16_t* __restrict__ act, float* __restrict__ sm1, float* __restrict__ sm2,
                                           float* __restrict__ pconv, float* __restrict__ sconv) {
    const int tid = opaque_tid();
    const int c0 = tid * 8, pc0 = ((MODE == 1) ? 2048 : 0) + c0;
    float wt[4][8], bias[8];
#pragma unroll
    for (int tap = 0; tap < 4; ++tap) { const float4 a = *(const float4*)(cw + tap * 4096 + c0), b = *(const float4*)(cw + tap * 4096 + c0 + 4);
        wt[tap][0] = a.x; wt[tap][1] = a.y; wt[tap][2] = a.z; wt[tap][3] = a.w; wt[tap][4] = b.x; wt[tap][5] = b.y; wt[tap][6] = b.z; wt[tap][7] = b.w; }
#pragma unroll
    for (int j = 0; j < 8; ++j) bias[j] = (MODE == 1) ? cb[c0 + j] : 0.f;
    const int nsm = (MODE == 1) ? 32 : 16;
    float hb = 0.f, hA = 0.f;
    if (tid < nsm) { hb = dt_bias[tid]; hA = -__expf(a_log[tid]); }
    for (int unit = bid; unit < 256 + NSB; unit += G) {
        const bool samp = unit >= 256;
        int row0, nrows, b, tfirst;
        if (!samp) { b = unit >> 5; tfirst = (unit & 31) * 64; row0 = b * PL + tfirst; nrows = 64; }
        else { b = unit - 256; tfirst = 0; row0 = TP + b * SL; nrows = SL; }
        const int L = samp ? SL : PL;
        float h[3][8];
#pragma unroll
        for (int i = 0; i < 3; ++i) {
            if (samp) { const float4 a = *(const float4*)(cstate + ((size_t)b * 3 + i) * 4096 + c0), bb = *(const float4*)(cstate + ((size_t)b * 3 + i) * 4096 + c0 + 4);
                h[i][0] = a.x; h[i][1] = a.y; h[i][2] = a.z; h[i][3] = a.w; h[i][4] = bb.x; h[i][5] = bb.y; h[i][6] = bb.z; h[i][7] = bb.w; }
            else if (tfirst > 0) unpack_bf8(*(const uint4*)(proj + (size_t)(row0 - 3 + i) * NIN + pc0), h[i]);
            else {
#pragma unroll
                for (int j = 0; j < 8; ++j) h[i][j] = 0.f; }
        }
        float csum = 0.f;
        constexpr int CB = 8;
        uint4 nraw[CB]; bf16_t ns1[CB], ns2[CB];
#pragma unroll
        for (int k = 0; k < CB; ++k) {
            ns1[k] = 0; ns2[k] = 0; nraw[k] = make_uint4(0u, 0u, 0u, 0u);
            if (k < nrows) {
                nraw[k] = ld_nt_u4(proj + (size_t)(row0 + k) * NIN + pc0);
                if (tid < nsm) { ns1[k] = proj[(size_t)(row0 + k) * NIN + 6144 + tid]; if (MODE == 2) ns2[k] = proj[(size_t)(row0 + k) * NIN + 6160 + tid]; }
            }
        }
#pragma unroll 1
        for (int r0 = 0; r0 < nrows; r0 += CB) {
            uint4 craw[CB]; bf16_t cs1[CB], cs2[CB];
#pragma unroll
            for (int k = 0; k < CB; ++k) { craw[k] = nraw[k]; cs1[k] = ns1[k]; cs2[k] = ns2[k]; }
            if (r0 + CB < nrows) {
#pragma unroll
                for (int k = 0; k < CB; ++k) {
                    nraw[k] = ld_nt_u4(proj + (size_t)(row0 + r0 + CB + k) * NIN + pc0);
                    if (tid < nsm) { ns1[k] = proj[(size_t)(row0 + r0 + CB + k) * NIN + 6144 + tid]; if (MODE == 2) ns2[k] = proj[(size_t)(row0 + r0 + CB + k) * NIN + 6160 + tid]; }
                }
            }
#pragma unroll
            for (int k = 0; k < CB; ++k) {
                if (r0 + k >= nrows) break;
                const int row = row0 + r0 + k, t = tfirst + r0 + k;
                float raw[8]; unpack_bf8(craw[k], raw);
                float a[8];
#pragma unroll
                for (int j = 0; j < 8; ++j) {
                    const float acc = bias[j] + h[0][j] * wt[0][j] + h[1][j] * wt[1][j] + h[2][j] * wt[2][j] + raw[j] * wt[3][j];
                    a[j] = silu_f(acc);
                    h[0][j] = h[1][j]; h[1][j] = h[2][j]; h[2][j] = raw[j];
                }
                if (MODE == 2) {
                    if (tid < 256) {
                        float ss = 0.f;
#pragma unroll
                        for (int j = 0; j < 8; ++j) ss += a[j] * a[j];
                        ss = row16_sum(ss);
                        const float sc = rsqrtf(ss + EPS) * ((tid < 128) ? 0.08838834764831845f : 1.f);
#pragma unroll
                        for (int j = 0; j < 8; ++j) a[j] *= sc;
                    }
                }
                uint4 pk; pk.x = pack_bf2(a[0], a[1]); pk.y = pack_bf2(a[2], a[3]); pk.z = pack_bf2(a[4], a[5]); pk.w = pack_bf2(a[6], a[7]);
                *(uint4*)(act + (size_t)row * 4096 + c0) = pk;
                if (t >= L - 3) {
                    float* dst = (samp ? sconv : pconv) + ((size_t)b * 3 + (t - (L - 3))) * 4096 + c0;
                    *(float4*)dst = make_float4(raw[0], raw[1], raw[2], raw[3]); *(float4*)(dst + 4) = make_float4(raw[4], raw[5], raw[6], raw[7]);
                }
                if (tid < nsm) {
                    if (MODE == 1) {
                        const float dt = softplus_f(bf2f(cs1[k]) + hb);
                        csum += dt * hA;
                        sm1[(size_t)row * 32 + tid] = dt; sm2[(size_t)row * 32 + tid] = csum;
                    } else {
                        const float beta = sigmoid_f(bf2f(cs1[k]));
                        const float g = hA * softplus_f(bf2f(cs2[k]) + hb);
                        csum += g;
                        sm1[(size_t)row * 16 + tid] = beta; sm2[(size_t)row * 32 + tid] = g; sm2[(size_t)row * 32 + 16 + tid] = csum;
                    }
                }
            }
        }
    }
}

__device__ __forceinline__ void k_ret_scan(unsigned char* lds, const int bid, const int G, const bf16_t* __restrict__ proj, const bf16_t* __restrict__ rope_qk, const float* __restrict__ s_in  ,
                                                 float* __restrict__ ymix, float* __restrict__ p_out, float* __restrict__ s_out) {
    float (*qs)[256] = (float (*)[256])lds; float (*ks)[256] = (float (*)[256])(lds + 4096); float (*vs)[64] = (float (*)[64])(lds + 8192); float (*red)[4][64] = (float (*)[4][64])(lds + 9216);
    const int tid = opaque_tid(), lane = tid & 63, wv = tid >> 6, c4 = tid & 15, dg = tid >> 4;
    const int tt_l = tid >> 7, i_l = tid & 127, t2 = (tid >> 6) & 3, cv = tid & 63;
    float4 Sn[8]; bf16_t nq0 = 0, nq1 = 0, nk0 = 0, nk1 = 0, nv = 0;
    int unit = NPB * 32 + bid;
    if (unit < NSEQ * 32) {
        const int sb = (unit >> 5) - NPB, h = (unit >> 3) & 3, sl = unit & 7;
        const size_t so = (((size_t)sb * 4 + h) * 256) * 512 + sl * 64 + c4 * 4;
#pragma unroll
        for (int r = 0; r < 8; ++r) Sn[r] = ld_nt4(s_in + so + (size_t)(dg * 8 + r) * 512);
        const size_t rb = (size_t)(TP + sb * SL + tt_l) * 4096;
        nq0 = rope_qk[rb + h * 256 + i_l]; nq1 = rope_qk[rb + h * 256 + 128 + i_l]; nk0 = rope_qk[rb + 1024 + h * 256 + i_l]; nk1 = rope_qk[rb + 1024 + h * 256 + 128 + i_l];
        if (tid < 256) nv = proj[(size_t)(TP + sb * SL + t2) * NIN + 2048 + h * 512 + sl * 64 + cv];
    }
    for (; unit < NSEQ * 32; unit += G) {
        const int sb = (unit >> 5) - NPB, h = (unit >> 3) & 3, sl = unit & 7;
        const int tok0 = TP + sb * SL;
        const float gamma = 1.f - exp2f(-5.f - (float)h);
        const size_t st_off = (((size_t)sb * 4 + h) * 256) * 512 + sl * 64 + c4 * 4;
        float S[8][4];
#pragma unroll
        for (int r = 0; r < 8; ++r) { S[r][0] = Sn[r].x; S[r][1] = Sn[r].y; S[r][2] = Sn[r].z; S[r][3] = Sn[r].w; }
        __syncthreads();
        qs[tt_l][i_l] = bf2f(nq0); qs[tt_l][i_l + 128] = bf2f(nq1); ks[tt_l][i_l] = bf2f(nk0); ks[tt_l][i_l + 128] = bf2f(nk1);
        if (tid < 256) vs[t2][cv] = bf2f(nv);
        __syncthreads();
        {
            const int un = unit + G;
            if (un < NSEQ * 32) {
                const int sb2 = (un >> 5) - NPB, h2 = (un >> 3) & 3, sl2 = un & 7;
                const size_t so = (((size_t)sb2 * 4 + h2) * 256) * 512 + sl2 * 64 + c4 * 4;
#pragma unroll
                for (int r = 0; r < 8; ++r) Sn[r] = ld_nt4(s_in + so + (size_t)(dg * 8 + r) * 512);
                const size_t rb = (size_t)(TP + sb2 * SL + tt_l) * 4096;
                nq0 = rope_qk[rb + h2 * 256 + i_l]; nq1 = rope_qk[rb + h2 * 256 + 128 + i_l]; nk0 = rope_qk[rb + 1024 + h2 * 256 + i_l]; nk1 = rope_qk[rb + 1024 + h2 * 256 + 128 + i_l];
                if (tid < 256) nv = proj[(size_t)(TP + sb2 * SL + t2) * NIN + 2048 + h2 * 512 + sl2 * 64 + cv];
            }
        }
#pragma unroll 1
        for (int tt = 0; tt < 4; ++tt) {
            const float4 vv = *(const float4*)(&vs[tt][c4 * 4]);
            const float vvv[4] = { vv.x, vv.y, vv.z, vv.w };
            float yp[4] = { 0.f, 0.f, 0.f, 0.f };
#pragma unroll
            for (int r = 0; r < 8; ++r) {
                const float kk = ks[tt][dg * 8 + r], qq = qs[tt][dg * 8 + r];
#pragma unroll
                for (int j = 0; j < 4; ++j) { S[r][j] = gamma * S[r][j] + kk * vvv[j]; yp[j] += qq * S[r][j]; }
            }
#pragma unroll
            for (int j = 0; j < 4; ++j) { float v = yp[j]; v += __shfl_xor(v, 16); v += __shfl_xor(v, 32); yp[j] = v; }
            if (lane < 16) *(float4*)(&red[wv][tt][c4 * 4]) = make_float4(yp[0], yp[1], yp[2], yp[3]);
        }
        __syncthreads();
        if (tid < 256) {
            const int tt = tid >> 6, c = tid & 63; float a = 0.f;
#pragma unroll
            for (int w = 0; w < 8; ++w) a += red[w][tt][c];
            ymix[(size_t)(tok0 + tt) * 2048 + h * 512 + sl * 64 + c] = a;
        }
#pragma unroll
        for (int r = 0; r < 8; ++r) st_nt4(s_out + st_off + (size_t)(dg * 8 + r) * 512, S[r][0], S[r][1], S[r][2], S[r][3]);
    }
}

__device__ __forceinline__ void k_ssd_scan(unsigned char* lds, const int bid, const int G, const bf16_t* __restrict__ act, const float* __restrict__ dtv, const float* __restrict__ a_log, const float* __restrict__ dskip,
                                                 const float* __restrict__ s_in  , float* __restrict__ ymix, float* __restrict__ p_out, float* __restrict__ s_out) {
    float (*xs)[64] = (float (*)[64])lds; float (*Bs)[128] = (float (*)[128])(lds + 1024); float (*Cs)[128] = (float (*)[128])(lds + 3072); float* dts = (float*)(lds + 5120);
    const int tid = opaque_tid(), n4 = tid & 31, pg = tid >> 5;
    const int tt_l = tid >> 7, i_l = tid & 127;
    float4 Sn[4]; bf16_t nB = 0, nC = 0, nX = 0; float nD = 0.f;
    int unit = NPB * 32 + bid;
    if (unit < NSEQ * 32) {
        const int sb = (unit >> 5) - NPB, hh = unit & 31, g = hh >> 2;
#pragma unroll
        for (int r = 0; r < 4; ++r) Sn[r] = ld_nt4(s_in + (((size_t)sb * 32 + hh) * 64 + pg * 4 + r) * 128 + n4 * 4);
        const size_t rb = (size_t)(TP + sb * SL + tt_l) * 4096;
        nB = act[rb + 2048 + g * 128 + i_l]; nC = act[rb + 3072 + g * 128 + i_l]; if (i_l < 64) nX = act[rb + hh * 64 + i_l];
        if (i_l == 64) nD = dtv[(size_t)(TP + sb * SL + tt_l) * 32 + hh];
    }
    for (; unit < NSEQ * 32; unit += G) {
        const int sb = (unit >> 5) - NPB, hh = unit & 31;
        const int tok0 = TP + sb * SL;
        const float A = -__expf(a_log[hh]), Dk = dskip[hh];
        const size_t st_off = (((size_t)sb * 32 + hh) * 64) * 128 + n4 * 4;
        float S[4][4];
#pragma unroll
        for (int r = 0; r < 4; ++r) { S[r][0] = Sn[r].x; S[r][1] = Sn[r].y; S[r][2] = Sn[r].z; S[r][3] = Sn[r].w; }
        __syncthreads();
        Bs[tt_l][i_l] = bf2f(nB); Cs[tt_l][i_l] = bf2f(nC); if (i_l < 64) xs[tt_l][i_l] = bf2f(nX); if (i_l == 64) dts[tt_l] = nD;
        __syncthreads();
        {
            const int un = unit + G;
            if (un < NSEQ * 32) {
                const int sb2 = (un >> 5) - NPB, hh2 = un & 31, g2 = hh2 >> 2;
#pragma unroll
                for (int r = 0; r < 4; ++r) Sn[r] = ld_nt4(s_in + (((size_t)sb2 * 32 + hh2) * 64 + pg * 4 + r) * 128 + n4 * 4);
                const size_t rb = (size_t)(TP + sb2 * SL + tt_l) * 4096;
                nB = act[rb + 2048 + g2 * 128 + i_l]; nC = act[rb + 3072 + g2 * 128 + i_l]; if (i_l < 64) nX = act[rb + hh2 * 64 + i_l];
                if (i_l == 64) nD = dtv[(size_t)(TP + sb2 * SL + tt_l) * 32 + hh2];
            }
        }
#pragma unroll
        for (int tt = 0; tt < 4; ++tt) {
            const float dt = dts[tt], a = __expf(dt * A);
            const float4 bv = *(const float4*)(&Bs[tt][n4 * 4]), cv = *(const float4*)(&Cs[tt][n4 * 4]);
            const float bb[4] = { bv.x, bv.y, bv.z, bv.w }, cc[4] = { cv.x, cv.y, cv.z, cv.w };
            float yp[4];
#pragma unroll
            for (int r = 0; r < 4; ++r) {
                const float xv = xs[tt][pg * 4 + r], xd = xv * dt;
                float acc = 0.f;
#pragma unroll
                for (int j = 0; j < 4; ++j) { S[r][j] = a * S[r][j] + xd * bb[j]; acc += S[r][j] * cc[j]; }
                acc = half_sum(acc);
                yp[r] = acc + Dk * xv;
            }
            if (n4 == 0) *(float4*)(ymix + (size_t)(tok0 + tt) * 2048 + hh * 64 + pg * 4) = make_float4(yp[0], yp[1], yp[2], yp[3]);
        }
#pragma unroll
        for (int r = 0; r < 4; ++r) st_nt4(s_out + st_off + (size_t)(pg * 4 + r) * 128, S[r][0], S[r][1], S[r][2], S[r][3]);
    }
}

__device__ __forceinline__ void k_gdn_scan(unsigned char* lds, const int bid, const int G, const bf16_t* __restrict__ act, const float* __restrict__ betav, const float* __restrict__ gv,
                                                 const float* __restrict__ s_in  , float* __restrict__ ymix, float* __restrict__ p_out, float* __restrict__ s_out) {
    float (*qs)[128] = (float (*)[128])lds; float (*ks)[128] = (float (*)[128])(lds + 2048); float (*vs)[128] = (float (*)[128])(lds + 4096); float* gs = (float*)(lds + 6144); float* bs = (float*)(lds + 6160);
    float (*red)[8][128] = (float (*)[8][128])(lds + 6400); float (*ored)[4][128] = (float (*)[4][128])(lds + 6400 + 8192);
    const int tid = opaque_tid(), lane = tid & 63, wv = tid >> 6, v4 = tid & 31, kg = tid >> 5;
    const int tt_l = tid >> 7, i_l = tid & 127;
    float4 Sn[8]; bf16_t nq = 0, nk = 0, nvv = 0; float ng = 0.f, nb = 0.f;
    int unit = NPB * 16 + bid;
    if (unit < NSEQ * 16) {
        const int sb = (unit >> 4) - NPB, hv = unit & 15, hk = hv >> 1;
        const size_t so = (((size_t)sb * 16 + hv) * 128) * 128 + v4 * 4;
#pragma unroll
        for (int r = 0; r < 8; ++r) Sn[r] = ld_nt4(s_in + so + (size_t)(kg * 8 + r) * 128);
        const size_t row = (size_t)(TP + sb * SL + tt_l), rb = row * 4096;
        nq = act[rb + hk * 128 + i_l]; nk = act[rb + 1024 + hk * 128 + i_l]; nvv = act[rb + 2048 + hv * 128 + i_l];
        if (i_l == 0) { ng = gv[row * 32 + hv]; nb = betav[row * 16 + hv]; }
    }
    for (; unit < NSEQ * 16; unit += G) {
        const int sb = (unit >> 4) - NPB, hv = unit & 15;
        const int tok0 = TP + sb * SL;
        const size_t st_off = (((size_t)sb * 16 + hv) * 128) * 128 + v4 * 4;
        float S[8][4];
#pragma unroll
        for (int r = 0; r < 8; ++r) { S[r][0] = Sn[r].x; S[r][1] = Sn[r].y; S[r][2] = Sn[r].z; S[r][3] = Sn[r].w; }
        __syncthreads();
        qs[tt_l][i_l] = bf2f(nq); ks[tt_l][i_l] = bf2f(nk); vs[tt_l][i_l] = bf2f(nvv);
        if (i_l == 0) { gs[tt_l] = ng; bs[tt_l] = nb; }
        __syncthreads();
        {
            const int un = unit + G;
            if (un < NSEQ * 16) {
                const int sb2 = (un >> 4) - NPB, hv2 = un & 15, hk2 = hv2 >> 1;
                const size_t so = (((size_t)sb2 * 16 + hv2) * 128) * 128 + v4 * 4;
#pragma unroll
                for (int r = 0; r < 8; ++r) Sn[r] = ld_nt4(s_in + so + (size_t)(kg * 8 + r) * 128);
                const size_t row = (size_t)(TP + sb2 * SL + tt_l), rb = row * 4096;
                nq = act[rb + hk2 * 128 + i_l]; nk = act[rb + 1024 + hk2 * 128 + i_l]; nvv = act[rb + 2048 + hv2 * 128 + i_l];
                if (i_l == 0) { ng = gv[row * 32 + hv2]; nb = betav[row * 16 + hv2]; }
            }
        }
#pragma unroll 1
        for (int tt = 0; tt < 4; ++tt) {
            const float eg = __expf(gs[tt]), beta = bs[tt];
            float kr[8], part[4] = { 0.f, 0.f, 0.f, 0.f };
#pragma unroll
            for (int r = 0; r < 8; ++r) {
                kr[r] = ks[tt][kg * 8 + r];
#pragma unroll
                for (int j = 0; j < 4; ++j) { S[r][j] *= eg; part[j] += S[r][j] * kr[r]; }
            }
#pragma unroll
            for (int j = 0; j < 4; ++j) part[j] += __shfl_xor(part[j], 32);
            if (lane < 32) *(float4*)(&red[tt & 1][wv][v4 * 4]) = make_float4(part[0], part[1], part[2], part[3]);
            __syncthreads();
            float kS[4] = { 0.f, 0.f, 0.f, 0.f };
#pragma unroll
            for (int w = 0; w < 8; ++w) { const float4 pv = *(const float4*)(&red[tt & 1][w][v4 * 4]); kS[0] += pv.x; kS[1] += pv.y; kS[2] += pv.z; kS[3] += pv.w; }
            const float4 vv = *(const float4*)(&vs[tt][v4 * 4]);
            const float dl[4] = { beta * (vv.x - kS[0]), beta * (vv.y - kS[1]), beta * (vv.z - kS[2]), beta * (vv.w - kS[3]) };
            float op[4] = { 0.f, 0.f, 0.f, 0.f };
#pragma unroll
            for (int r = 0; r < 8; ++r) {
                const float qq = qs[tt][kg * 8 + r];
#pragma unroll
                for (int j = 0; j < 4; ++j) { S[r][j] += kr[r] * dl[j]; op[j] += S[r][j] * qq; }
            }
#pragma unroll
            for (int j = 0; j < 4; ++j) op[j] += __shfl_xor(op[j], 32);
            if (lane < 32) *(float4*)(&ored[wv][tt][v4 * 4]) = make_float4(op[0], op[1], op[2], op[3]);
        }
        __syncthreads();
        {
            const int tt = tid >> 7, c = tid & 127; float a = 0.f;
#pragma unroll
            for (int w = 0; w < 8; ++w) a += ored[w][tt][c];
            ymix[(size_t)(tok0 + tt) * 2048 + hv * 128 + c] = a;
        }
#pragma unroll
        for (int r = 0; r < 8; ++r) st_nt4(s_out + st_off + (size_t)(kg * 8 + r) * 128, S[r][0], S[r][1], S[r][2], S[r][3]);
    }
}

typedef pg8::bf16x8 bf16x8;
typedef pg8::f32x4 f32x4;
typedef pg8::u32x4 u32x4;
typedef pg8::u32x2 u32x2;
#define MFMA16(a, b, c) __builtin_amdgcn_mfma_f32_16x16x32_bf16((a), (b), (c), 0, 0, 0)
__device__ __forceinline__ bf16x8 ld_frag(LAS unsigned char* base, int row, int ld, int k) { return *(const LAS bf16x8*)(base + (row * ld + k) * 2); }
__device__ __forceinline__ u32x2 pack_bf4(float a, float b, float c, float d) { u32x2 r; r.x = pg8::cvt_pk_bf16(a, b); r.y = pg8::cvt_pk_bf16(c, d); return r; }
__device__ __forceinline__ float lds_bf(LAS unsigned char* base, int idx) { return __uint_as_float(((uint32_t)*(const LAS bf16_t*)(base + idx * 2)) << 16); }

template <int KS>
__device__ __forceinline__ void mma_2tiles(f32x4 (&acc)[2], LAS unsigned char* A, int arow, int lda, LAS unsigned char* B, int brow0, int brow1, int ldb, int quad) {
    constexpr int KB = (KS < 4) ? KS : 4;
#pragma unroll
    for (int kh = 0; kh < KS / KB; ++kh) {
        bf16x8 fa[KB], fb0[KB], fb1[KB];
#pragma unroll
        for (int ks = 0; ks < KB; ++ks) { const int k = (kh * KB + ks) * 32 + quad * 8; fa[ks] = ld_frag(A, arow, lda, k); fb0[ks] = ld_frag(B, brow0, ldb, k); fb1[ks] = ld_frag(B, brow1, ldb, k); }
        __builtin_amdgcn_sched_barrier(0);
#pragma unroll
        for (int ks = 0; ks < KB; ++ks) { acc[0] = MFMA16(fa[ks], fb0[ks], acc[0]); acc[1] = MFMA16(fa[ks], fb1[ks], acc[1]); }
        __builtin_amdgcn_sched_barrier(0);
    }
}
template <int MT>
__device__ __forceinline__ void mma_state(f32x4 (&acc)[MT][4], LAS unsigned char* A, int arow0, int lda, LAS unsigned char* B, int ldb, int l15, int quad) {
    bf16x8 fa[2][MT], fb[2][4];
#pragma unroll
    for (int ks = 0; ks < 2; ++ks) {
#pragma unroll
        for (int m = 0; m < MT; ++m) fa[ks][m] = ld_frag(A, arow0 + 16 * m + l15, lda, ks * 32 + quad * 8);
#pragma unroll
        for (int n = 0; n < 4; ++n) fb[ks][n] = ld_frag(B, n * 16 + l15, ldb, ks * 32 + quad * 8);
    }
    __builtin_amdgcn_sched_barrier(0);
#pragma unroll
    for (int ks = 0; ks < 2; ++ks)
#pragma unroll
        for (int m = 0; m < MT; ++m)
#pragma unroll
            for (int n = 0; n < 4; ++n) acc[m][n] = MFMA16(fa[ks][m], fb[ks][n], acc[m][n]);
    __builtin_amdgcn_sched_barrier(0);
}

constexpr int SC_CS = 0, SC_BS = SC_CS + 64 * 136 * 2, SC_BT = SC_BS + 64 * 136 * 2, SC_XR = SC_BT + 128 * 72 * 2, SC_XT = SC_XR + 64 * 72 * 2, SC_XD = SC_XT + 64 * 72 * 2,
              SC_ST = SC_XD + 64 * 72 * 2, SC_PS = SC_ST + 64 * 136 * 2, SC_CT = SC_PS + 64 * 72 * 2, SC_DT = SC_CT + 256, SC_END = SC_DT + 256;
static_assert(SC_END <= 131072, "ssd chunk LDS");
__device__ __forceinline__ void k_ssd_chunk(unsigned char* lds_, const int bid, const int G, const bf16_t* __restrict__ act, const float* __restrict__ dtv, const float* __restrict__ ctv,
                                            const float* __restrict__ dskip, float* __restrict__ ymix, float* __restrict__ p_out) {
    LAS unsigned char* lds = (LAS unsigned char*)lds_;
    const int tid = opaque_tid(), lane = tid & 63, w = __builtin_amdgcn_readfirstlane(tid >> 6), l15 = lane & 15, quad = lane >> 4;
    LAS float* ctl = (LAS float*)(lds + SC_CT); LAS float* dtl = (LAS float*)(lds + SC_DT);
    for (int unit = bid; unit < NPB * 32; unit += G) {
        const int un = xcd_unit(unit, G), b = un >> 5, hh = un & 31, g = hh >> 2;
        const float Dk = dskip[hh];
        f32x4 Sacc[4];
#pragma unroll
        for (int i = 0; i < 4; ++i) Sacc[i] = (f32x4){0.f, 0.f, 0.f, 0.f};
        for (int i = tid; i < 64 * 136 / 8; i += NT) *(LAS u32x4*)(lds + SC_ST + i * 16) = (u32x4){0u, 0u, 0u, 0u};
        u32x4 rc[2], rb[2], rx; float rct = 0.f, rdt = 0.f;
        const int r_cb = tid >> 4, c_cb = (tid & 15) * 8;
        const int r_x = tid >> 3, c_x = (tid & 7) * 8;
        {
            const size_t rowbase = (size_t)b * PL;
#pragma unroll
            for (int k = 0; k < 2; ++k) { const bf16_t* rp = act + (rowbase + r_cb + 32 * k) * 4096; rc[k] = *(const u32x4*)(rp + 3072 + g * 128 + c_cb); rb[k] = *(const u32x4*)(rp + 2048 + g * 128 + c_cb); }
            rx = __builtin_nontemporal_load((const u32x4*)(act + (rowbase + r_x) * 4096 + hh * 64 + c_x));
            if (tid < 64) { rct = ctv[(rowbase + tid) * 32 + hh]; rdt = dtv[(rowbase + tid) * 32 + hh]; }
        }
        for (int c = 0; c < 32; ++c) {
            const size_t rowbase = (size_t)b * PL + c * 64;
#pragma unroll
            for (int k = 0; k < 2; ++k) { *(LAS u32x4*)(lds + SC_CS + ((r_cb + 32 * k) * 136 + c_cb) * 2) = rc[k]; *(LAS u32x4*)(lds + SC_BS + ((r_cb + 32 * k) * 136 + c_cb) * 2) = rb[k]; }
            *(LAS u32x4*)(lds + SC_XR + (r_x * 72 + c_x) * 2) = rx;
            if (tid < 64) { ctl[tid] = rct; dtl[tid] = rdt; }
            __syncthreads();
            if (c + 1 < 32) {
                const size_t nb = rowbase + 64;
#pragma unroll
                for (int k = 0; k < 2; ++k) { const bf16_t* rp = act + (nb + r_cb + 32 * k) * 4096; rc[k] = *(const u32x4*)(rp + 3072 + g * 128 + c_cb); rb[k] = *(const u32x4*)(rp + 2048 + g * 128 + c_cb); }
                rx = __builtin_nontemporal_load((const u32x4*)(act + (nb + r_x) * 4096 + hh * 64 + c_x));
                if (tid < 64) { rct = ctv[(nb + tid) * 32 + hh]; rdt = dtv[(nb + tid) * 32 + hh]; }
            }
            const float ct63 = ctl[63];
#pragma unroll
            for (int k = 0; k < 2; ++k) {
                const int idx = tid + NT * k, n = idx & 127, s8 = idx >> 7;
                uint32_t v[8];
#pragma unroll
                for (int j = 0; j < 8; ++j) v[j] = *(const LAS bf16_t*)(lds + SC_BS + ((s8 * 8 + j) * 136 + n) * 2);
                *(LAS u32x4*)(lds + SC_BT + (n * 72 + s8 * 8) * 2) = (u32x4){v[0] | (v[1] << 16), v[2] | (v[3] << 16), v[4] | (v[5] << 16), v[6] | (v[7] << 16)};
            }
            {
                const int p = tid & 63, s8 = tid >> 6;
                float a[8], d[8];
#pragma unroll
                for (int j = 0; j < 8; ++j) { const int s_ = s8 * 8 + j; a[j] = lds_bf(lds + SC_XR, s_ * 72 + p) * dtl[s_]; d[j] = a[j] * __expf(ct63 - ctl[s_]); }
                u32x4 o; o.x = pg8::cvt_pk_bf16(a[0], a[1]); o.y = pg8::cvt_pk_bf16(a[2], a[3]); o.z = pg8::cvt_pk_bf16(a[4], a[5]); o.w = pg8::cvt_pk_bf16(a[6], a[7]);
                *(LAS u32x4*)(lds + SC_XT + (p * 72 + s8 * 8) * 2) = o;
                o.x = pg8::cvt_pk_bf16(d[0], d[1]); o.y = pg8::cvt_pk_bf16(d[2], d[3]); o.z = pg8::cvt_pk_bf16(d[4], d[5]); o.w = pg8::cvt_pk_bf16(d[6], d[7]);
                *(LAS u32x4*)(lds + SC_XD + (p * 72 + s8 * 8) * 2) = o;
            }
            __syncthreads();
            const int mi = w >> 1, nb2 = (w & 1) * 2;
            {
                f32x4 acc[2] = { (f32x4){0.f, 0.f, 0.f, 0.f}, (f32x4){0.f, 0.f, 0.f, 0.f} };
                mma_2tiles<4>(acc, lds + SC_BS, mi * 16 + l15, 136, lds + SC_CS, nb2 * 16 + l15, nb2 * 16 + 16 + l15, 136, quad);
                const int s0 = mi * 16 + quad * 4;
#pragma unroll
                for (int ni = 0; ni < 2; ++ni) {
                    const int t = (nb2 + ni) * 16 + l15; const float ctt = ctl[t];
                    float pv[4];
#pragma unroll
                    for (int j = 0; j < 4; ++j) pv[j] = (s0 + j <= t) ? acc[ni][j] * __expf(ctt - ctl[s0 + j]) : 0.f;
                    *(LAS u32x2*)(lds + SC_PS + (t * 72 + s0) * 2) = pack_bf4(pv[0], pv[1], pv[2], pv[3]);
                }
            }
            f32x4 yacc[2] = { (f32x4){0.f, 0.f, 0.f, 0.f}, (f32x4){0.f, 0.f, 0.f, 0.f} };
            mma_2tiles<4>(yacc, lds + SC_ST, mi * 16 + l15, 136, lds + SC_CS, nb2 * 16 + l15, nb2 * 16 + 16 + l15, 136, quad);
#pragma unroll
            for (int ni = 0; ni < 2; ++ni) yacc[ni] *= __expf(ctl[(nb2 + ni) * 16 + l15]);
            __syncthreads();
            mma_2tiles<2>(yacc, lds + SC_XT, mi * 16 + l15, 72, lds + SC_PS, nb2 * 16 + l15, nb2 * 16 + 16 + l15, 72, quad);
#pragma unroll
            for (int ni = 0; ni < 2; ++ni) {
                const int t = (nb2 + ni) * 16 + l15, p0 = mi * 16 + quad * 4;
                const u32x2 xr = *(const LAS u32x2*)(lds + SC_XR + (t * 72 + p0) * 2);
                f32x4 o = yacc[ni];
                o[0] += Dk * __uint_as_float(xr.x << 16); o[1] += Dk * __uint_as_float(xr.x & 0xffff0000u); o[2] += Dk * __uint_as_float(xr.y << 16); o[3] += Dk * __uint_as_float(xr.y & 0xffff0000u);
                __builtin_nontemporal_store(o, (f32x4*)(ymix + (rowbase + t) * 2048 + hh * 64 + p0));
            }
            {
                const float e63 = __expf(ct63);
#pragma unroll
                for (int ni = 0; ni < 4; ++ni) Sacc[ni] *= e63;
                mma_state<1>(*(f32x4 (*)[1][4])&Sacc, lds + SC_BT, w * 16, 72, lds + SC_XD, 72, l15, quad);
            }
            __syncthreads();
#pragma unroll
            for (int ni = 0; ni < 4; ++ni) *(LAS u32x2*)(lds + SC_ST + ((ni * 16 + l15) * 136 + w * 16 + quad * 4) * 2) = pack_bf4(Sacc[ni][0], Sacc[ni][1], Sacc[ni][2], Sacc[ni][3]);
        }
#pragma unroll
        for (int ni = 0; ni < 4; ++ni) __builtin_nontemporal_store(Sacc[ni], (f32x4*)(p_out + (((size_t)b * 32 + hh) * 64 + ni * 16 + l15) * 128 + w * 16 + quad * 4));
        __syncthreads();
    }
}

__device__ __forceinline__ void k_ret_pre(unsigned char* lds, const int bid, const int G, const bf16_t* __restrict__ proj, const float* __restrict__ rope, bf16_t* __restrict__ qk) {
    const int tid = opaque_tid(), lane = tid & 63, w = tid >> 6;
    for (int row = bid * 8 + w; row < T; row += G * 8) {
        const int prow = (row < TP) ? (row & (PL - 1)) : PL + ((row - TP) & (SL - 1));
        const float4 cs = *(const float4*)(rope + ((size_t)prow * 128 + lane * 2) * 2);
        const uint32_t* src = (const uint32_t*)(proj + (size_t)row * NIN);
        uint32_t* dst = (uint32_t*)(qk + (size_t)row * 4096);
#pragma unroll
        for (int hd = 0; hd < 8; ++hd) {
            const uint32_t a = __builtin_nontemporal_load(src + hd * 128 + lane), b = __builtin_nontemporal_load(src + hd * 128 + 64 + lane);
            const float x1a = __uint_as_float(a << 16), x1b = __uint_as_float(a & 0xffff0000u), x2a = __uint_as_float(b << 16), x2b = __uint_as_float(b & 0xffff0000u);
            const float sc = (hd < 4) ? 1.f : 0.0625f;
            dst[hd * 128 + lane] = pack_bf2((x1a * cs.x - x2a * cs.y) * sc, (x1b * cs.z - x2b * cs.w) * sc);
            dst[hd * 128 + 64 + lane] = pack_bf2((x1a * cs.y + x2a * cs.x) * sc, (x1b * cs.w + x2b * cs.z) * sc);
        }
    }
}

constexpr int RC_QS = 0, RC_KS = RC_QS + 64 * 264 * 2, RC_KT = RC_KS + 64 * 264 * 2, RC_VT = RC_KT + 256 * 72 * 2, RC_ST = RC_VT + 64 * 72 * 2, RC_PS = RC_ST + 64 * 264 * 2, RC_END = RC_PS + 64 * 72 * 2, RC_GP = RC_END;
__device__ __forceinline__ void k_ret_chunk(unsigned char* lds_, const int bid, const int G, const bf16_t* __restrict__ qk, const bf16_t* __restrict__ proj, float* __restrict__ ymix, float* __restrict__ p_out) {
    LAS unsigned char* lds = (LAS unsigned char*)lds_;
    const int tid = opaque_tid(), lane = tid & 63, w = __builtin_amdgcn_readfirstlane(tid >> 6), l15 = lane & 15, quad = lane >> 4;
    for (int unit = bid; unit < NPB * 32; unit += G) {
        const int un = xcd_unit(unit, G), b = un >> 5, h = (un >> 3) & 3, sl = un & 7;
        const float lg = log2f(1.f - exp2f(-5.f - (float)h));
        f32x4 Sacc[2][4];
#pragma unroll
        for (int i = 0; i < 2; ++i)
#pragma unroll
            for (int j = 0; j < 4; ++j) Sacc[i][j] = (f32x4){0.f, 0.f, 0.f, 0.f};
        for (int i = tid; i < 64 * 264 / 8; i += NT) *(LAS u32x4*)(lds + RC_ST + i * 16) = (u32x4){0u, 0u, 0u, 0u};
        LAS float* gpw = (LAS float*)(lds + RC_GP);
        if (tid < 65) gpw[tid] = __builtin_amdgcn_exp2f((float)tid * lg);
        u32x4 rq[4], rk[4], rv;
        const int r_qk = tid >> 5, c_qk = (tid & 31) * 8;
        const int r_v = tid >> 3, c_v = (tid & 7) * 8;
        {
            const size_t rowbase = (size_t)b * PL;
#pragma unroll
            for (int k = 0; k < 4; ++k) { const bf16_t* rp = qk + (rowbase + r_qk + 16 * k) * 4096 + h * 256 + c_qk; rq[k] = *(const u32x4*)rp; rk[k] = *(const u32x4*)(rp + 1024); }
            rv = __builtin_nontemporal_load((const u32x4*)(proj + (rowbase + r_v) * NIN + 2048 + h * 512 + sl * 64 + c_v));
        }
        for (int c = 0; c < 32; ++c) {
            const size_t rowbase = (size_t)b * PL + c * 64;
#pragma unroll
            for (int k = 0; k < 4; ++k) { *(LAS u32x4*)(lds + RC_QS + ((r_qk + 16 * k) * 264 + c_qk) * 2) = rq[k]; *(LAS u32x4*)(lds + RC_KS + ((r_qk + 16 * k) * 264 + c_qk) * 2) = rk[k]; }
            *(LAS u32x4*)(lds + RC_PS + (r_v * 72 + c_v) * 2) = rv;
            __syncthreads();
            if (c + 1 < 32) {
                const size_t nb = rowbase + 64;
#pragma unroll
                for (int k = 0; k < 4; ++k) { const bf16_t* rp = qk + (nb + r_qk + 16 * k) * 4096 + h * 256 + c_qk; rq[k] = *(const u32x4*)rp; rk[k] = *(const u32x4*)(rp + 1024); }
                rv = __builtin_nontemporal_load((const u32x4*)(proj + (nb + r_v) * NIN + 2048 + h * 512 + sl * 64 + c_v));
            }
            int tz = tid; asm volatile("" : "+v"(tz));
            const int l15z = tz & 15, quadz = (tz & 63) >> 4;
#pragma unroll
            for (int k = 0; k < 4; ++k) {
                const int idx = tz + NT * k, d = idx & 255, s8 = idx >> 8;
                float a[8];
#pragma unroll
                for (int j = 0; j < 8; ++j) a[j] = lds_bf(lds + RC_KS, (s8 * 8 + j) * 264 + d) * gpw[63 - s8 * 8 - j];
                u32x4 o; o.x = pg8::cvt_pk_bf16(a[0], a[1]); o.y = pg8::cvt_pk_bf16(a[2], a[3]); o.z = pg8::cvt_pk_bf16(a[4], a[5]); o.w = pg8::cvt_pk_bf16(a[6], a[7]);
                *(LAS u32x4*)(lds + RC_KT + (d * 72 + s8 * 8) * 2) = o;
            }
            {
                const int v = tz & 63, s8 = tz >> 6;
                uint32_t x[8];
#pragma unroll
                for (int j = 0; j < 8; ++j) x[j] = *(const LAS bf16_t*)(lds + RC_PS + ((s8 * 8 + j) * 72 + v) * 2);
                *(LAS u32x4*)(lds + RC_VT + (v * 72 + s8 * 8) * 2) = (u32x4){x[0] | (x[1] << 16), x[2] | (x[3] << 16), x[4] | (x[5] << 16), x[6] | (x[7] << 16)};
            }
            __syncthreads();
            const int mi = w >> 1, nb2 = (w & 1) * 2;
            {
                f32x4 acc[2] = { (f32x4){0.f, 0.f, 0.f, 0.f}, (f32x4){0.f, 0.f, 0.f, 0.f} };
                mma_2tiles<8>(acc, lds + RC_KS, mi * 16 + l15, 264, lds + RC_QS, nb2 * 16 + l15, nb2 * 16 + 16 + l15, 264, quad);
                const int s0 = mi * 16 + quadz * 4;
#pragma unroll
                for (int ni = 0; ni < 2; ++ni) {
                    const int t = (nb2 + ni) * 16 + l15z;
                    float pv[4];
#pragma unroll
                    for (int j = 0; j < 4; ++j) pv[j] = (s0 + j <= t) ? acc[ni][j] * gpw[t - s0 - j] : 0.f;
                    *(LAS u32x2*)(lds + RC_PS + (t * 72 + s0) * 2) = pack_bf4(pv[0], pv[1], pv[2], pv[3]);
                }
            }
            f32x4 yacc[2] = { (f32x4){0.f, 0.f, 0.f, 0.f}, (f32x4){0.f, 0.f, 0.f, 0.f} };
            mma_2tiles<8>(yacc, lds + RC_ST, mi * 16 + l15, 264, lds + RC_QS, nb2 * 16 + l15, nb2 * 16 + 16 + l15, 264, quad);
#pragma unroll
            for (int ni = 0; ni < 2; ++ni) yacc[ni] *= gpw[(nb2 + ni) * 16 + l15z + 1];
            __syncthreads();
            mma_2tiles<2>(yacc, lds + RC_VT, mi * 16 + l15, 72, lds + RC_PS, nb2 * 16 + l15, nb2 * 16 + 16 + l15, 72, quad);
#pragma unroll
            for (int ni = 0; ni < 2; ++ni) __builtin_nontemporal_store(yacc[ni], (f32x4*)(ymix + (rowbase + (nb2 + ni) * 16 + l15) * 2048 + h * 512 + sl * 64 + mi * 16 + quad * 4));
            {
                const float e64 = gpw[64];
#pragma unroll
                for (int m2 = 0; m2 < 2; ++m2)
#pragma unroll
                    for (int ni = 0; ni < 4; ++ni) Sacc[m2][ni] *= e64;
                mma_state<2>(Sacc, lds + RC_KT, 2 * w * 16, 72, lds + RC_VT, 72, l15, quad);
            }
            __syncthreads();
#pragma unroll
            for (int m2 = 0; m2 < 2; ++m2)
#pragma unroll
                for (int ni = 0; ni < 4; ++ni)
                    *(LAS u32x2*)(lds + RC_ST + ((ni * 16 + l15) * 264 + (2 * w + m2) * 16 + quad * 4) * 2) = pack_bf4(Sacc[m2][ni][0], Sacc[m2][ni][1], Sacc[m2][ni][2], Sacc[m2][ni][3]);
        }
#pragma unroll
        for (int m2 = 0; m2 < 2; ++m2)
#pragma unroll
            for (int ni = 0; ni < 4; ++ni)
#pragma unroll
                for (int j = 0; j < 4; ++j)
                    __builtin_nontemporal_store(Sacc[m2][ni][j], p_out + (((size_t)b * 4 + h) * 256 + (2 * w + m2) * 16 + quad * 4 + j) * 512 + sl * 64 + ni * 16 + l15);
        __syncthreads();
    }
}

constexpr int GA_HALF = 71424, GA_KS = 0, GA_QS = 17408, GA_LM = 34816, GA_GC = 52224, GA_BE = 52480, GA_E63 = 52736, GA_EGC = 52992, GA_BEG = 53248, GA_VS = 53504;
__device__ __forceinline__ void k_gdn_p2a(unsigned char* lds_, const int bid, const int G, const bf16_t* __restrict__ act, const float* __restrict__ betav, const float* __restrict__ gv,
                                          bf16_t* __restrict__ Ug, bf16_t* __restrict__ Wg, bf16_t* __restrict__ Qdg, bf16_t* __restrict__ KdTg, bf16_t* __restrict__ Atg) {
    const int tid = opaque_tid(), half = __builtin_amdgcn_readfirstlane(tid >> 8), ht = tid & 255, lane = tid & 63, wh = __builtin_amdgcn_readfirstlane((tid >> 6) & 3), l15 = lane & 15, quad = lane >> 4;
    LAS unsigned char* lds = (LAS unsigned char*)lds_ + half * GA_HALF;
    LAS float* gcl = (LAS float*)(lds + GA_GC); LAS float* bel = (LAS float*)(lds + GA_BE); LAS float* Lm = (LAS float*)(lds + GA_LM);
    LAS float* e63l = (LAS float*)(lds + GA_E63); LAS float* egcl = (LAS float*)(lds + GA_EGC); LAS float* begl = (LAS float*)(lds + GA_BEG);
    u32x4 nq[4], nk[4], nv[4]; float ngc = 0.f, nbt = 0.f, ng63 = 0.f;
    if (bid * 2 < NPB * 16 * 32) {
        const int unit = bid * 2 + half, chunk = unit & 31, hv = (unit >> 5) & 15, b = unit >> 9, hk = hv >> 1;
        const size_t rowbase = (size_t)b * PL + chunk * 64;
        { const size_t rr = rowbase + (ht & 63); ngc = gv[rr * 32 + 16 + hv]; nbt = betav[rr * 16 + hv]; ng63 = gv[(rowbase + 63) * 32 + 16 + hv]; }
#pragma unroll
        for (int k = 0; k < 4; ++k) {
            const int idx = ht + 256 * k, r = idx >> 4, c8 = (idx & 15) * 8;
            const bf16_t* rp = act + (rowbase + r) * 4096 + hk * 128 + c8;
            nq[k] = *(const u32x4*)rp; nk[k] = *(const u32x4*)(rp + 1024); nv[k] = __builtin_nontemporal_load((const u32x4*)(act + (rowbase + r) * 4096 + 2048 + hv * 128 + c8));
        }
    }
    for (int u0 = bid * 2; u0 < NPB * 16 * 32; u0 += G * 2) {
        const int unit = u0 + half, chunk = unit & 31, hv = (unit >> 5) & 15, b = unit >> 9, hk = hv >> 1;
        const size_t rowbase = (size_t)b * PL + chunk * 64;
        __syncthreads();
#pragma unroll
        for (int k = 0; k < 4; ++k) {
            const int idx = ht + 256 * k, r = idx >> 4, c8 = (idx & 15) * 8;
            *(LAS u32x4*)(lds + GA_QS + (r * 136 + c8) * 2) = nq[k];
            *(LAS u32x4*)(lds + GA_KS + (r * 136 + c8) * 2) = nk[k];
            *(LAS u32x4*)(lds + GA_VS + (r * 136 + c8) * 2) = nv[k];
        }
        if (ht < 64) { const float gch = ngc, bt = nbt, g63h = ng63, eg = __expf(gch);
            gcl[ht] = gch; bel[ht] = bt; e63l[ht] = __expf(g63h - gch); egcl[ht] = eg; begl[ht] = bt * eg; }
        __syncthreads();
        {
            f32x4 akk[4], aqk[4];
#pragma unroll
            for (int ni = 0; ni < 4; ++ni) { akk[ni] = (f32x4){0.f, 0.f, 0.f, 0.f}; aqk[ni] = (f32x4){0.f, 0.f, 0.f, 0.f}; }
#pragma unroll
            for (int kh = 0; kh < 2; ++kh) {
                bf16x8 fa[2], fk[2][4], fq[2][4];
#pragma unroll
                for (int ks = 0; ks < 2; ++ks) { const int k = (kh * 2 + ks) * 32 + quad * 8; fa[ks] = ld_frag(lds + GA_KS, wh * 16 + l15, 136, k);
#pragma unroll
                    for (int ni = 0; ni < 4; ++ni) { fk[ks][ni] = ld_frag(lds + GA_KS, ni * 16 + l15, 136, k); fq[ks][ni] = ld_frag(lds + GA_QS, ni * 16 + l15, 136, k); } }
                __builtin_amdgcn_sched_barrier(0);
#pragma unroll
                for (int ks = 0; ks < 2; ++ks)
#pragma unroll
                    for (int ni = 0; ni < 4; ++ni) { akk[ni] = MFMA16(fa[ks], fk[ks][ni], akk[ni]); aqk[ni] = MFMA16(fa[ks], fq[ks][ni], aqk[ni]); }
                __builtin_amdgcn_sched_barrier(0);
            }
            const int s0 = wh * 16 + quad * 4;
#pragma unroll
            for (int ni = 0; ni < 4; ++ni) {
                const int t = ni * 16 + l15; const float gt = gcl[t], bt = bel[t];
                float lv[4], av[4];
#pragma unroll
                for (int j = 0; j < 4; ++j) { const float e = __expf(gt - gcl[s0 + j]); lv[j] = (s0 + j < t) ? bt * akk[ni][j] * e : 0.f; av[j] = (s0 + j <= t) ? aqk[ni][j] * e : 0.f; }
                *(LAS f32x4*)(Lm + t * 68 + s0) = (f32x4){lv[0], lv[1], lv[2], lv[3]};
                *(u32x2*)(Atg + ((size_t)unit * 64 + t) * 64 + s0) = pack_bf4(av[0], av[1], av[2], av[3]);
            }
        }
        {
#pragma unroll
            for (int k = 0; k < 4; ++k) {
                const int idx = ht + 256 * k, t = idx >> 4, c8 = (idx & 15) * 8;
                float f[8]; const u32x4 raw = *(const LAS u32x4*)(lds + GA_QS + (t * 136 + c8) * 2);
                unpack_bf8(make_uint4(raw.x, raw.y, raw.z, raw.w), f);
                const float e = egcl[t];
                u32x4 o; o.x = pg8::cvt_pk_bf16(f[0] * e, f[1] * e); o.y = pg8::cvt_pk_bf16(f[2] * e, f[3] * e); o.z = pg8::cvt_pk_bf16(f[4] * e, f[5] * e); o.w = pg8::cvt_pk_bf16(f[6] * e, f[7] * e);
                *(u32x4*)(Qdg + ((size_t)unit * 64 + t) * 128 + c8) = o;
            }
#pragma unroll
            for (int k = 0; k < 4; ++k) {
                const int idx = ht + 256 * k, d = idx & 127, s8 = idx >> 7;
                float a[8];
#pragma unroll
                for (int j = 0; j < 8; ++j) a[j] = lds_bf(lds + GA_KS, (s8 * 8 + j) * 136 + d) * e63l[s8 * 8 + j];
                u32x4 o; o.x = pg8::cvt_pk_bf16(a[0], a[1]); o.y = pg8::cvt_pk_bf16(a[2], a[3]); o.z = pg8::cvt_pk_bf16(a[4], a[5]); o.w = pg8::cvt_pk_bf16(a[6], a[7]);
                *(u32x4*)(KdTg + ((size_t)unit * 128 + d) * 64 + s8 * 8) = o;
            }
        }
        float x[64];
        if (ht < 128) {
#pragma unroll
            for (int t = 0; t < 64; ++t) x[t] = bel[t] * lds_bf(lds + GA_VS, t * 136 + ht);
        } else {
#pragma unroll
            for (int t = 0; t < 64; ++t) x[t] = begl[t] * lds_bf(lds + GA_KS, t * 136 + ht - 128);
        }
        __syncthreads();
#pragma unroll
        for (int t = 1; t < 64; ++t) {
            f32x4 l[16];
#pragma unroll
            for (int q = 0; q < (t + 3) / 4; ++q) l[q] = *(const LAS f32x4*)(Lm + t * 68 + q * 4);
            __builtin_amdgcn_sched_barrier(0);
            float a0 = x[t], a1 = 0.f, a2 = 0.f, a3 = 0.f;
#pragma unroll
            for (int q = 0; q < (t + 3) / 4; ++q) { a0 -= l[q][0] * x[4 * q]; a1 -= l[q][1] * x[4 * q + 1]; a2 -= l[q][2] * x[4 * q + 2]; a3 -= l[q][3] * x[4 * q + 3]; }
            x[t] = (a0 + a1) + (a2 + a3);
            __builtin_amdgcn_sched_barrier(0);
        }
        {
            LAS unsigned char* stg = lds + ((ht < 128) ? GA_QS : GA_KS); const int cc = ht & 127;
#pragma unroll
            for (int t = 0; t < 64; ++t) *(LAS bf16_t*)(stg + (t * 136 + cc) * 2) = f2bf(x[t]);
            {
                const int un = (u0 + G * 2 < NPB * 16 * 32) ? u0 + G * 2 + half : unit, chunk2 = un & 31, hv2 = (un >> 5) & 15, b2 = un >> 9, hk2 = hv2 >> 1;
                const size_t rb2 = (size_t)b2 * PL + chunk2 * 64;
                { const size_t rr = rb2 + (ht & 63); ngc = gv[rr * 32 + 16 + hv2]; nbt = betav[rr * 16 + hv2]; ng63 = gv[(rb2 + 63) * 32 + 16 + hv2]; }
#pragma unroll
                for (int k = 0; k < 4; ++k) {
                    const int idx = ht + 256 * k, r = idx >> 4, c8 = (idx & 15) * 8;
                    const bf16_t* rp = act + (rb2 + r) * 4096 + hk2 * 128 + c8;
                    nq[k] = *(const u32x4*)rp; nk[k] = *(const u32x4*)(rp + 1024); nv[k] = __builtin_nontemporal_load((const u32x4*)(act + (rb2 + r) * 4096 + 2048 + hv2 * 128 + c8));
                }
            }
            __syncthreads();
#pragma unroll
            for (int k = 0; k < 4; ++k) {
                const int idx = ht + 256 * k, r = idx >> 4, c8 = (idx & 15) * 8;
                __builtin_nontemporal_store(*(const LAS u32x4*)(lds + GA_QS + (r * 136 + c8) * 2), (u32x4*)(Ug + ((size_t)unit * 64 + r) * 128 + c8));
                *(u32x4*)(Wg + ((size_t)unit * 64 + r) * 128 + c8) = *(const LAS u32x4*)(lds + GA_KS + (r * 136 + c8) * 2);
            }
        }
    }
}

constexpr int GB_WS = 0, GB_QD = GB_WS + 64 * 136 * 2, GB_KT = GB_QD + 64 * 136 * 2, GB_AT = GB_KT + 128 * 72 * 2, GB_US = GB_AT + 64 * 72 * 2, GB_ST = GB_US + 64 * 72 * 2, GB_VN = GB_ST + 64 * 136 * 2, GB_END = GB_VN + 64 * 72 * 2;
__device__ __forceinline__ void k_gdn_p2b(unsigned char* lds_, const int bid, const int G, const bf16_t* __restrict__ Ug, const bf16_t* __restrict__ Wg, const bf16_t* __restrict__ Qdg, const bf16_t* __restrict__ KdTg,
                                          const bf16_t* __restrict__ Atg, const float* __restrict__ gv, float* __restrict__ ymix, float* __restrict__ p_out) {
    LAS unsigned char* lds = (LAS unsigned char*)lds_;
    const int tid = opaque_tid(), lane = tid & 63, w = __builtin_amdgcn_readfirstlane(tid >> 6), l15 = lane & 15, quad = lane >> 4;
    for (int unit = bid; unit < NPB * 32; unit += G) {
        const int un = xcd_unit(unit, G), b = un >> 5, hv = (un >> 1) & 15, vh = un & 1;
        f32x4 Sacc[4];
#pragma unroll
        for (int i = 0; i < 4; ++i) Sacc[i] = (f32x4){0.f, 0.f, 0.f, 0.f};
        for (int i = tid; i < 64 * 136 / 8; i += NT) *(LAS u32x4*)(lds + GB_ST + i * 16) = (u32x4){0u, 0u, 0u, 0u};
        u32x4 rw[2], rqd[2], rkt[2], rat, ru;
        const int r_a = tid >> 4, c_a = (tid & 15) * 8;
        const int r_k = tid >> 3, c_k = (tid & 7) * 8;
        const size_t ua0 = ((size_t)b * 16 + hv) * 32;
        {
#pragma unroll
            for (int k = 0; k < 2; ++k) {
                rw[k] = *(const u32x4*)(Wg + (ua0 * 64 + r_a + 32 * k) * 128 + c_a); rqd[k] = *(const u32x4*)(Qdg + (ua0 * 64 + r_a + 32 * k) * 128 + c_a);
                rkt[k] = *(const u32x4*)(KdTg + (ua0 * 128 + r_k + 64 * k) * 64 + c_k);
            }
            rat = *(const u32x4*)(Atg + (ua0 * 64 + r_k) * 64 + c_k);
            ru = __builtin_nontemporal_load((const u32x4*)(Ug + (ua0 * 64 + r_k) * 128 + vh * 64 + c_k));
        }
        float rg63 = gv[((size_t)b * PL + 63) * 32 + 16 + hv];
        for (int c = 0; c < 32; ++c) {
            const size_t rowbase = (size_t)b * PL + c * 64;
            const float g63 = rg63;
#pragma unroll
            for (int k = 0; k < 2; ++k) {
                *(LAS u32x4*)(lds + GB_WS + ((r_a + 32 * k) * 136 + c_a) * 2) = rw[k]; *(LAS u32x4*)(lds + GB_QD + ((r_a + 32 * k) * 136 + c_a) * 2) = rqd[k];
                *(LAS u32x4*)(lds + GB_KT + ((r_k + 64 * k) * 72 + c_k) * 2) = rkt[k];
            }
            *(LAS u32x4*)(lds + GB_AT + (r_k * 72 + c_k) * 2) = rat;
            *(LAS u32x4*)(lds + GB_US + (r_k * 72 + c_k) * 2) = ru;
            __syncthreads();
            if (c + 1 < 32) {
                const size_t ua = ua0 + c + 1;
#pragma unroll
                for (int k = 0; k < 2; ++k) {
                    rw[k] = *(const u32x4*)(Wg + (ua * 64 + r_a + 32 * k) * 128 + c_a); rqd[k] = *(const u32x4*)(Qdg + (ua * 64 + r_a + 32 * k) * 128 + c_a);
                    rkt[k] = *(const u32x4*)(KdTg + (ua * 128 + r_k + 64 * k) * 64 + c_k);
                }
                rat = *(const u32x4*)(Atg + (ua * 64 + r_k) * 64 + c_k);
                ru = __builtin_nontemporal_load((const u32x4*)(Ug + (ua * 64 + r_k) * 128 + vh * 64 + c_k));
                rg63 = gv[(rowbase + 64 + 63) * 32 + 16 + hv];
            }
            const int mi = w >> 1, nb2 = (w & 1) * 2;
            f32x4 oacc[2] = { (f32x4){0.f, 0.f, 0.f, 0.f}, (f32x4){0.f, 0.f, 0.f, 0.f} };
            {
                f32x4 acc[2] = { (f32x4){0.f, 0.f, 0.f, 0.f}, (f32x4){0.f, 0.f, 0.f, 0.f} };
                mma_2tiles<4>(acc, lds + GB_WS, mi * 16 + l15, 136, lds + GB_ST, nb2 * 16 + l15, nb2 * 16 + 16 + l15, 136, quad);
                mma_2tiles<4>(oacc, lds + GB_ST, mi * 16 + l15, 136, lds + GB_QD, nb2 * 16 + l15, nb2 * 16 + 16 + l15, 136, quad);
                const int t0 = mi * 16 + quad * 4;
#pragma unroll
                for (int ni = 0; ni < 2; ++ni) {
                    const int v = (nb2 + ni) * 16 + l15;
                    float vn[4];
#pragma unroll
                    for (int j = 0; j < 4; ++j) vn[j] = lds_bf(lds + GB_US, (t0 + j) * 72 + v) - acc[ni][j];
                    *(LAS u32x2*)(lds + GB_VN + (v * 72 + t0) * 2) = pack_bf4(vn[0], vn[1], vn[2], vn[3]);
                }
            }
            __syncthreads();
            mma_2tiles<2>(oacc, lds + GB_VN, mi * 16 + l15, 72, lds + GB_AT, nb2 * 16 + l15, nb2 * 16 + 16 + l15, 72, quad);
#pragma unroll
            for (int ni = 0; ni < 2; ++ni) __builtin_nontemporal_store(oacc[ni], (f32x4*)(ymix + (rowbase + (nb2 + ni) * 16 + l15) * 2048 + hv * 128 + vh * 64 + mi * 16 + quad * 4));
            {
                const float e63 = __expf(g63);
#pragma unroll
                for (int ni = 0; ni < 4; ++ni) Sacc[ni] *= e63;
                mma_state<1>(*(f32x4 (*)[1][4])&Sacc, lds + GB_KT, w * 16, 72, lds + GB_VN, 72, l15, quad);
            }
            __syncthreads();
#pragma unroll
            for (int ni = 0; ni < 4; ++ni) *(LAS u32x2*)(lds + GB_ST + ((ni * 16 + l15) * 136 + w * 16 + quad * 4) * 2) = pack_bf4(Sacc[ni][0], Sacc[ni][1], Sacc[ni][2], Sacc[ni][3]);
        }
#pragma unroll
        for (int ni = 0; ni < 4; ++ni)
#pragma unroll
            for (int j = 0; j < 4; ++j) __builtin_nontemporal_store(Sacc[ni][j], p_out + (((size_t)b * 16 + hv) * 128 + w * 16 + quad * 4 + j) * 128 + vh * 64 + ni * 16 + l15);
        __syncthreads();
    }
}

template <int EPI, int BN, int BK>
__device__ __forceinline__ void k_gemm_small(unsigned char* lds_, const int bid, const int G, const bf16_t* __restrict__ A, const bf16_t* __restrict__ Bt, const int N, const int K,
                                             const float* __restrict__ base, float* __restrict__ outf, bf16_t* __restrict__ outb, const pg8::SsqRef ssq) {
    constexpr int LDK = BK + 8, NT16 = BN / 32, CPR = BK / 8  , RPP = NT / CPR  , NA = 64 / RPP, NB = BN / RPP;
    constexpr int GS_AS = 0, GS_BS = 64 * LDK * 2;
    static_assert(GS_BS + BN * LDK * 2 <= 131072, "small gemm LDS");
    LAS unsigned char* lds = (LAS unsigned char*)lds_;
    const int tid = opaque_tid(), lane = tid & 63, w = __builtin_amdgcn_readfirstlane(tid >> 6), l15 = lane & 15, quad = lane >> 4;
    const int mi = w >> 1, ng = w & 1;
    const int r_t = tid / CPR, c_t = (tid % CPR) * 8;
    for (int item = bid; item < 8 * (N / BN); item += G) {
        const int mt = item & 7, nt = item >> 3;
        const bf16_t* Ap = A + (size_t)(mt * 64 + r_t) * K + c_t;
        const bf16_t* Bp = Bt + (size_t)(nt * BN + r_t) * K + c_t;
        u32x4 ra[NA], rb[NB];
#pragma unroll
        for (int k = 0; k < NA; ++k) ra[k] = *(const u32x4*)(Ap + (size_t)RPP * k * K);
#pragma unroll
        for (int k = 0; k < NB; ++k) rb[k] = *(const u32x4*)(Bp + (size_t)RPP * k * K);
        float bsv[4][NT16];
#pragma unroll
        for (int j = 0; j < 4; ++j)
#pragma unroll
            for (int n = 0; n < NT16; ++n) bsv[j][n] = (EPI == 0) ? __builtin_nontemporal_load(base + (size_t)(mt * 64 + mi * 16 + quad * 4 + j) * N + nt * BN + (ng * NT16 + n) * 16 + l15) : 0.f;
        float rsv[4] = {1.f, 1.f, 1.f, 1.f};
        if (EPI == 1) {
#pragma unroll
            for (int j = 0; j < 4; ++j) rsv[j] = pg8::row_rs(ssq, TP + mt * 64 + mi * 16 + quad * 4 + j);
        }
        f32x4 acc[NT16];
#pragma unroll
        for (int n = 0; n < NT16; ++n) acc[n] = (f32x4){0.f, 0.f, 0.f, 0.f};
        for (int k0 = 0; k0 < K; k0 += BK) {
            __syncthreads();
#pragma unroll
            for (int k = 0; k < NA; ++k) *(LAS u32x4*)(lds + GS_AS + ((r_t + RPP * k) * LDK + c_t) * 2) = ra[k];
#pragma unroll
            for (int k = 0; k < NB; ++k) *(LAS u32x4*)(lds + GS_BS + ((r_t + RPP * k) * LDK + c_t) * 2) = rb[k];
            __syncthreads();
            if (k0 + BK < K) {
#pragma unroll
                for (int k = 0; k < NA; ++k) ra[k] = *(const u32x4*)(Ap + (size_t)RPP * k * K + k0 + BK);
#pragma unroll
                for (int k = 0; k < NB; ++k) rb[k] = *(const u32x4*)(Bp + (size_t)RPP * k * K + k0 + BK);
            }
#pragma unroll
            for (int kb = 0; kb < BK / 128; ++kb) {
                bf16x8 fa[4], fb[4][NT16];
#pragma unroll
                for (int ks = 0; ks < 4; ++ks) { const int k = (kb * 4 + ks) * 32 + quad * 8; fa[ks] = ld_frag(lds + GS_AS, mi * 16 + l15, LDK, k);
#pragma unroll
                    for (int n = 0; n < NT16; ++n) fb[ks][n] = ld_frag(lds + GS_BS, (ng * NT16 + n) * 16 + l15, LDK, k); }
                __builtin_amdgcn_sched_barrier(0);
#pragma unroll
                for (int ks = 0; ks < 4; ++ks)
#pragma unroll
                    for (int n = 0; n < NT16; ++n) acc[n] = MFMA16(fa[ks], fb[ks][n], acc[n]);
                __builtin_amdgcn_sched_barrier(0);
            }
        }
#pragma unroll
        for (int j = 0; j < 4; ++j) {
            const int row = mt * 64 + mi * 16 + quad * 4 + j;
            float ss = 0.f;
#pragma unroll
            for (int n = 0; n < NT16; ++n) {
                const size_t o = (size_t)row * N + nt * BN + (ng * NT16 + n) * 16 + l15;
                if (EPI == 0) { const float x = bsv[j][n] + acc[n][j]; __builtin_nontemporal_store(x, outf + o); outb[o] = f2bf(x); ss += x * x; }
                else { const float r = fmaxf(acc[n][j], 0.f) * rsv[j]; outb[o] = f2bf(r * r); }
            }
            if (EPI == 0) {
                ss = row16_sum(ss);
                if (l15 == 0) ssq.p64[(size_t)row * 64 + nt * 2 + ng] = ss;
            }
        }
    }
}

constexpr int LDS_BYTES = 156672 + 1024;
constexpr int RST_OFF = 131072;

#define GRID_BAR() do { REPEAT(REP_BAR) xcd_barrier(xbar); } while (0)

__device__ __forceinline__ pg8::SsqRef ssq_ref(const P& p, int inst) { pg8::SsqRef r; r.p16 = p.ssq + (size_t)inst * TP * 16; r.p64 = p.ssq + (size_t)9 * TP * 16 + (size_t)inst * TS * 64; return r; }

template <int L>
__device__ __forceinline__ void layer_body(const P& p, unsigned char* lds, const int bid, const int G, const XcdBarrier& xbar) {
    constexpr int kind = L % 3, j = L / 3;
    REPEAT(REP_GEMM) {
    { pg8::Gemm g{p.xb, p.w_in[L], T, NIN, D}; pg8::StaticOrder S; S.init(T, NIN, G, bid); pg8::EpiProjS E{p.proj, NIN, (PG8_LAS unsigned char*)lds + RST_OFF};
      pg8::rs_table_build((PG8_LAS unsigned char*)lds + RST_OFF, S, ssq_ref(p, 2 * L), opaque_tid());
      pg8::gemm_phase<pg8::EpiProjS, pg8::StaticOrder>((PG8_LAS unsigned char*)lds, g, S, E, nullptr); }
    GRID_BAR(); }
    if (kind == 0) {
        REPEAT(REP_ELEM) { k_ret_pre(lds, bid, G, p.proj, p.rope, p.act); GRID_BAR(); }
        REPEAT(REP_CHUNK) k_ret_chunk(lds, bid, G, p.act, p.proj, p.ymix, p.out + O_PRET + (size_t)j * NPB * RET_ST);
        REPEAT(REP_SAMP) k_ret_scan(lds, bid, G, p.proj, p.act, p.in[2] + (size_t)j * NSB * RET_ST, p.ymix,
                   p.out + O_PRET + (size_t)j * NPB * RET_ST, p.out + O_SRET + (size_t)j * NSB * RET_ST);
        GRID_BAR();
        REPEAT(REP_ELEM) { k_gate<0>(lds, bid, G, p.ymix, p.proj, p.ab); GRID_BAR(); }
    } else if (kind == 1) {
        REPEAT(REP_ELEM) { k_conv_pre<1>(lds, bid, G, p.proj, p.in[4], p.in[13], p.in[14], p.in[15], p.in[16], p.act, p.sm1, p.sm2, p.out + O_PSSDC, p.out + O_SSSDC); GRID_BAR(); }
        REPEAT(REP_CHUNK) k_ssd_chunk(lds, bid, G, p.act, p.sm1, p.sm2, p.in[17], p.ymix, p.out + O_PSSD);
        REPEAT(REP_SAMP) k_ssd_scan(lds, bid, G, p.act, p.sm1, p.in[16], p.in[17], p.in[3], p.ymix, p.out + O_PSSD, p.out + O_SSSD);
        GRID_BAR();
        REPEAT(REP_ELEM) { k_gate<1>(lds, bid, G, p.ymix, p.proj, p.ab); GRID_BAR(); }
    } else {
        REPEAT(REP_ELEM) { k_conv_pre<2>(lds, bid, G, p.proj, p.in[6], p.in[21], nullptr, p.in[22], p.in[23], p.act, p.sm1, p.sm2, p.out + O_PGDNC, p.out + O_SGDNC); GRID_BAR(); }
        REPEAT(REP_CHUNK) k_gdn_p2a(lds, bid, G, p.act, p.sm1, p.sm2, p.gU, p.gW, p.gQd, p.gKdT, p.gAt);
        REPEAT(REP_SAMP) k_gdn_scan(lds, bid, G, p.act, p.sm1, p.sm2, p.in[5], p.ymix, p.out + O_PGDN, p.out + O_SGDN);
        GRID_BAR();
        REPEAT(REP_CHUNK) { k_gdn_p2b(lds, bid, G, p.gU, p.gW, p.gQd, p.gKdT, p.gAt, p.sm2, p.ymix, p.out + O_PGDN); GRID_BAR(); }
        REPEAT(REP_ELEM) { k_gate<2>(lds, bid, G, p.ymix, p.proj, p.ab); GRID_BAR(); }
    }
    REPEAT(REP_GEMM) {
    { pg8::Gemm g{p.ab, p.w_out[L], TP, D, 2048}; pg8::StaticOrder S; S.init(TP, D, G, bid); pg8::EpiResN E{p.xres, p.xres2, D, p.xb, ssq_ref(p, 2 * L + 1).p16};
      pg8::gemm_phase<pg8::EpiResN, pg8::StaticOrder>((PG8_LAS unsigned char*)lds, g, S, E, nullptr); }
    k_gemm_small<0, 32, 512>(lds, bid, G, p.ab + (size_t)TP * 2048, p.w_out[L], D, 2048, p.xres + (size_t)TP * D, p.xres2 + (size_t)TP * D, p.xb + (size_t)TP * D, ssq_ref(p, 2 * L + 1));
    GRID_BAR(); }
    REPEAT(REP_GEMM) {
    { pg8::Gemm g{p.xb, p.w_up[L], TP, DFF, D}; pg8::StaticOrder S; S.init(TP, DFF, G, bid); pg8::EpiSqrelu E{p.u, DFF, (PG8_LAS unsigned char*)lds + RST_OFF};
      pg8::rs_table_build((PG8_LAS unsigned char*)lds + RST_OFF, S, ssq_ref(p, 2 * L + 1), opaque_tid());
      pg8::gemm_phase<pg8::EpiSqrelu, pg8::StaticOrder>((PG8_LAS unsigned char*)lds, g, S, E, nullptr); }
    k_gemm_small<1, 128, 256>(lds, bid, G, p.xb + (size_t)TP * D, p.w_up[L], DFF, D, nullptr, nullptr, p.u + (size_t)TP * DFF, ssq_ref(p, 2 * L + 1));
    GRID_BAR(); }
    REPEAT(REP_GEMM) {
    { pg8::Gemm g{p.u, p.w_dn[L], TP, D, DFF}; pg8::StaticOrder S; S.init(TP, D, G, bid); pg8::EpiResN E{p.xres2, p.xres, D, p.xb, ssq_ref(p, 2 * L + 2).p16};
      pg8::gemm_phase<pg8::EpiResN, pg8::StaticOrder>((PG8_LAS unsigned char*)lds, g, S, E, nullptr); }
    k_gemm_small<0, 32, 512>(lds, bid, G, p.u + (size_t)TP * DFF, p.w_dn[L], D, DFF, p.xres2 + (size_t)TP * D, p.xres + (size_t)TP * D, p.xb + (size_t)TP * D, ssq_ref(p, 2 * L + 2));
    GRID_BAR(); }
}

__global__ void __launch_bounds__(NT, 2) mega_fwd(const P p) {
    extern __shared__ __attribute__((aligned(16))) unsigned char lds[];
    const int bid = blockIdx.x, G = gridDim.x;
    LAS unsigned* stw = (LAS unsigned*)(lds + LDS_BYTES - 16);
    if (threadIdx.x < 4) stw[threadIdx.x] = 0u;
    __syncthreads();
    const XcdBarrier xbar = xcd_barrier_post(p.bar, (volatile LAS unsigned*)stw);
    const float* norm_mix = p.in[7]; const float* norm_mlp = p.in[8];
    REPEAT(REP_P0) {
#pragma unroll
    for (int l = 0; l < 4; ++l) {
        const int kind = l % 3, j = l / 3;
        if (kind == 0) {
            k_prep_w(lds, bid, G, p.in[10] + (size_t)j * D * 6144, p.w_in[l], D, 6144, NIN, norm_mix + l * D, D);
            k_prep_w(lds, bid, G, p.in[11] + (size_t)j * 2048 * D, p.w_out[l], 2048, D, D, nullptr, 1);
        } else if (kind == 1) {
            k_prep_w(lds, bid, G, p.in[12], p.w_in[l], D, 6176, NIN, norm_mix + l * D, D);
            k_prep_w(lds, bid, G, p.in[19], p.w_out[l], 2048, D, D, p.in[18], 2048);
        } else {
            k_prep_w(lds, bid, G, p.in[20], p.w_in[l], D, 6176, NIN, norm_mix + l * D, D);
            k_prep_w(lds, bid, G, p.in[25], p.w_out[l], 2048, D, D, p.in[24], 128);
        }
        k_prep_w(lds, bid, G, p.in[26] + (size_t)l * D * DFF, p.w_up[l], D, DFF, DFF, norm_mlp + l * D, D);
        k_prep_w(lds, bid, G, p.in[27] + (size_t)l * DFF * D, p.w_dn[l], DFF, D, D, nullptr, 1);
    }
    k_rope(lds, bid, G, p.rope);
    k_x_prep(lds, bid, G, p.in[0], p.in[1], p.xres, p.xb, ssq_ref(p, 0));
    GRID_BAR(); }
    layer_body<0>(p, lds, bid, G, xbar);
    layer_body<1>(p, lds, bid, G, xbar);
    layer_body<2>(p, lds, bid, G, xbar);
    layer_body<3>(p, lds, bid, G, xbar);
    REPEAT(REP_ELEM) k_final_norm(lds, bid, G, p.xres, ssq_ref(p, 8), p.in[9], p.out);
}

static inline size_t al256(size_t x) { return (x + 255) & ~(size_t)255; }

extern "C" void kernel_launch(void* const* d_in, const int* in_sizes, int n_in, void* d_out, int out_size, void* d_ws, size_t ws_size, hipStream_t stream) {
    static int grid = 0;
    if (grid == 0) {
        int dev = 0, cus = 0, per_cu = 0;
        hipGetDevice(&dev);
        hipDeviceGetAttribute(&cus, hipDeviceAttributeMultiprocessorCount, dev);
        hipFuncSetAttribute((const void*)mega_fwd, hipFuncAttributeMaxDynamicSharedMemorySize, LDS_BYTES);
        hipOccupancyMaxActiveBlocksPerMultiprocessor(&per_cu, (const void*)mega_fwd, NT, LDS_BYTES);
        (void)hipGetLastError();
        if (cus <= 0) cus = 256;
        grid = cus;
    }
    P p{};
    for (int i = 0; i < 28; ++i) p.in[i] = (const float*)d_in[i];
    p.out = (float*)d_out;
    char* w = (char*)d_ws; size_t off = 65536;
    p.bar = (unsigned*)d_ws;
    auto take = [&](size_t bytes) { char* r = w + off; off = al256(off + bytes); return r; };
    p.ssq = (float*)take(((size_t)9 * TP * 16 + (size_t)9 * TS * 64) * 4);
    p.xres = (float*)take((size_t)T * D * 4);
    p.xres2 = (float*)take((size_t)T * D * 4);
    p.xb = (bf16_t*)take((size_t)T * D * 2);
    p.proj = (bf16_t*)take((size_t)T * NIN * 2);
    p.act = (bf16_t*)take((size_t)T * 4096 * 2);
    p.sm1 = (float*)take((size_t)T * 32 * 4);
    p.sm2 = (float*)take((size_t)T * 32 * 4);
    p.ymix = (float*)take((size_t)T * 2048 * 4);
    p.ab = (bf16_t*)take((size_t)T * 2048 * 2);
    p.u = (bf16_t*)take((size_t)T * DFF * 2);
    p.rope = (float*)take((size_t)(PL + SL) * 128 * 2 * 4);
    for (int l = 0; l < 4; ++l) {
        p.w_in[l] = (bf16_t*)take((size_t)NIN * D * 2);
        p.w_out[l] = (bf16_t*)take((size_t)D * 2048 * 2);
        p.w_up[l] = (bf16_t*)take((size_t)DFF * D * 2);
        p.w_dn[l] = (bf16_t*)take((size_t)D * DFF * 2);
    }
    p.gU = (bf16_t*)take((size_t)4096 * 64 * 128 * 2); p.gW = (bf16_t*)take((size_t)4096 * 64 * 128 * 2); p.gQd = (bf16_t*)take((size_t)4096 * 64 * 128 * 2);
    p.gKdT = (bf16_t*)take((size_t)4096 * 128 * 64 * 2); p.gAt = (bf16_t*)take((size_t)4096 * 64 * 64 * 2);
    hipMemsetAsync(d_ws, 0, 16384, stream);
    hipLaunchKernelGGL(mega_fwd, dim3(grid), dim3(NT), LDS_BYTES, stream, p);
}
```
